# Optimizing an MI355X kernel written in HIP

```python
import math
import jax
import jax.numpy as jnp
from jax import lax
import numpy as np

D_MODEL = 2048
BATCH = 2
SEQ = 8192
DEPTH = 2

N_META = 16
BLOCK = 128
PAD = BLOCK - N_META
RMS_EPS = 1e-6
GN_EPS = 1e-5
NEG = -1e30

DSA_HEADS = 8
DSA_HEAD_DIM = 128
DSA_LATENT = 256
IDX_HEADS = 16
IDX_DIM = 64
INDEX_TOPK = 256

FOX_HEADS = 8
FOX_HEAD_DIM = 128

RET_HEADS = 8
RET_QK_DIM = 64
RET_V_DIM = 128
ROPE_BASE = 10000.0

BRANCH_WIDTH = 1024
N_BRANCH = 3

T5_BUCKETS = 32
T5_MAX_EXACT = 16
T5_MAX_DIST = 128

D_FF = 5632

IN_WIDTHS = (
    DSA_HEADS * DSA_HEAD_DIM,
    DSA_LATENT,
    IDX_HEADS * IDX_DIM,
    IDX_DIM,
    IDX_HEADS,
    FOX_HEADS * FOX_HEAD_DIM,
    FOX_HEADS * FOX_HEAD_DIM,
    FOX_HEADS * FOX_HEAD_DIM,
    FOX_HEADS,
    RET_HEADS * RET_QK_DIM,
    RET_HEADS * RET_QK_DIM,
    RET_HEADS * RET_V_DIM,
    RET_HEADS * RET_V_DIM,
    N_BRANCH * D_MODEL,
)
D_IN = sum(IN_WIDTHS)

kernel_name = "hybrid_dsa_fox_retention_macaron"


def rmsnorm(x, g):
    xf = x.astype(jnp.float32)
    y = xf * lax.rsqrt(jnp.mean(xf * xf, axis=-1, keepdims=True) + RMS_EPS)
    return (y * g.astype(jnp.float32)).astype(x.dtype)


def swiglu(h, w1, w3, w2):
    return (jax.nn.silu(h @ w1) * (h @ w3)) @ w2


def split_cols(a):
    parts, start = [], 0
    for w in IN_WIDTHS:
        parts.append(a[..., start:start + w])
        start += w
    return parts


def to_blocks(a):
    b, t = a.shape[:2]
    return jnp.moveaxis(a.reshape((b, t // BLOCK, BLOCK) + a.shape[2:]), 1, 0)


def from_blocks(a):
    a = jnp.moveaxis(a, 0, 1)
    return a.reshape((a.shape[0], a.shape[1] * a.shape[2]) + a.shape[3:])


def admissible(tq, tk):
    return (tk <= tq) & ((tk >= PAD) | (tk == tq))


def t5_bucket(dist):
    d = jnp.maximum(dist, 1).astype(jnp.float32)
    large = T5_MAX_EXACT + (jnp.log(d / T5_MAX_EXACT) / math.log(T5_MAX_DIST / T5_MAX_EXACT)
                            * (T5_BUCKETS - T5_MAX_EXACT)).astype(jnp.int32)
    large = jnp.minimum(large, T5_BUCKETS - 1)
    return jnp.where(dist < T5_MAX_EXACT, dist, large)


def rope(x, pos):
    half = x.shape[-1] // 2
    inv = ROPE_BASE ** (-jnp.arange(half, dtype=jnp.float32) / half)
    ang = pos.astype(jnp.float32)[:, None] * inv[None, :]
    cos = jnp.cos(ang)[None, :, None, :].astype(x.dtype)
    sin = jnp.sin(ang)[None, :, None, :].astype(x.dtype)
    x1, x2 = x[..., :half], x[..., half:]
    return jnp.concatenate([x1 * cos - x2 * sin, x1 * sin + x2 * cos], axis=-1)


def dsa_branch(h_q, h_c, h_iq, h_ik, h_iw, kv_norm, w_uk, w_uv, t5_table, topk):
    b, t = h_q.shape[:2]
    pos = jnp.arange(t, dtype=jnp.int32)
    q = h_q.reshape(b, t, DSA_HEADS, DSA_HEAD_DIM)
    c = rmsnorm(h_c, kv_norm)
    q_lat = jnp.einsum("bthd,chd->bthc", q, w_uk) * DSA_HEAD_DIM ** -0.5
    qi = h_iq.reshape(b, t, IDX_HEADS, IDX_DIM) * IDX_DIM ** -0.5
    wi = h_iw * IDX_HEADS ** -0.5

    def block(args):
        ql, qib, wib, tq = args
        rel = jnp.einsum("bqhd,bsd->bqhs", qib, h_ik)
        score = jnp.einsum("bqhs,bqh->bqs", jax.nn.relu(rel), wib).astype(jnp.float32)
        score = jnp.where(admissible(tq[:, None], pos[None, :])[None], score, NEG)
        _, idx = lax.top_k(score, topk)
        c_sel = jax.vmap(lambda cb, ib: cb[ib])(c, idx)
        logit = jnp.einsum("bqhc,bqkc->bqhk", ql, c_sel).astype(jnp.float32)
        bias = t5_table[t5_bucket(jnp.maximum(tq[None, :, None] - idx, 0))]
        logit = logit + jnp.moveaxis(bias, -1, 2).astype(jnp.float32)
        ok = admissible(tq[None, :, None], idx)[:, :, None, :]
        p = jax.nn.softmax(jnp.where(ok, logit, NEG), axis=-1).astype(c.dtype)
        o_lat = jnp.einsum("bqhk,bqkc->bqhc", p, c_sel)
        o = jnp.einsum("bqhc,chd->bqhd", o_lat, w_uv)
        return o.reshape(b, BLOCK, DSA_HEADS * DSA_HEAD_DIM)

    out = lax.map(block, (to_blocks(q_lat), to_blocks(qi), to_blocks(wi), pos.reshape(-1, BLOCK)))
    return from_blocks(out)


def fox_branch(h_q, h_k, h_v, h_f, f_bias):
    b, t = h_q.shape[:2]
    pos = jnp.arange(t, dtype=jnp.int32)
    q = h_q.reshape(b, t, FOX_HEADS, FOX_HEAD_DIM) * FOX_HEAD_DIM ** -0.5
    k = h_k.reshape(b, t, FOX_HEADS, FOX_HEAD_DIM)
    v = h_v.reshape(b, t, FOX_HEADS, FOX_HEAD_DIM)
    log_f = jax.nn.log_sigmoid((h_f + f_bias).astype(jnp.float32))
    cum = jnp.cumsum(log_f, axis=1)
    cum_k = jnp.transpose(cum, (0, 2, 1))

    def block(args):
        qb, cq, tq = args
        logit = jnp.einsum("bqhd,bshd->bhqs", qb, k).astype(jnp.float32)
        logit = logit + jnp.transpose(cq, (0, 2, 1))[..., None] - cum_k[:, :, None, :]
        ok = admissible(tq[:, None], pos[None, :])
        p = jax.nn.softmax(jnp.where(ok, logit, NEG), axis=-1).astype(v.dtype)
        return jnp.einsum("bhqs,bshd->bqhd", p, v).reshape(b, BLOCK, FOX_HEADS * FOX_HEAD_DIM)

    out = lax.map(block, (to_blocks(q), to_blocks(cum), pos.reshape(-1, BLOCK)))
    return from_blocks(out)


def retention_branch(h_q, h_k, h_v, h_g, gn_w):
    b, t = h_q.shape[:2]
    n = t // BLOCK
    pos = jnp.arange(t, dtype=jnp.int32)
    q = rope(h_q.reshape(b, t, RET_HEADS, RET_QK_DIM), pos)
    k = rope(h_k.reshape(b, t, RET_HEADS, RET_QK_DIM), pos) * RET_QK_DIM ** -0.5
    k = jnp.where((pos >= PAD)[None, :, None, None], k, 0)
    v = h_v.reshape(b, t, RET_HEADS, RET_V_DIM)
    log_gamma = jnp.log1p(-(2.0 ** (-5.0 - jnp.arange(RET_HEADS, dtype=jnp.float32))))
    i = jnp.arange(BLOCK, dtype=jnp.float32)
    gap = i[:, None] - i[None, :]
    decay = jnp.where(gap[None] >= 0,
                      jnp.exp(jnp.maximum(gap, 0.0)[None] * log_gamma[:, None, None]),
                      0.0).astype(q.dtype)
    qc = q.reshape(b, n, BLOCK, RET_HEADS, RET_QK_DIM)
    kc = k.reshape(b, n, BLOCK, RET_HEADS, RET_QK_DIM)
    vc = v.reshape(b, n, BLOCK, RET_HEADS, RET_V_DIM)
    intra_s = jnp.einsum("bnihd,bnjhd->bnhij", qc, kc) * decay
    intra = jnp.einsum("bnhij,bnjhv->bnihv", intra_s, vc)
    k_dec = kc * jnp.exp((BLOCK - 1 - i)[:, None] * log_gamma[None, :])[..., None].astype(q.dtype)
    kv = jnp.einsum("bnjhd,bnjhv->nbhdv", k_dec, vc)
    chunk_decay = jnp.exp(BLOCK * log_gamma)[:, None, None].astype(kv.dtype)

    def step(state, kv_n):
        return chunk_decay * state + kv_n, state

    _, state_prev = lax.scan(step, jnp.zeros_like(kv[0]), kv)
    q_dec = qc * jnp.exp((i + 1.0)[:, None] * log_gamma[None, :])[..., None].astype(q.dtype)
    cross = jnp.einsum("bnihd,nbhdv->bnihv", q_dec, state_prev)
    o = (intra + cross).reshape(b, t, RET_HEADS, RET_V_DIM).astype(jnp.float32)
    mu = jnp.mean(o, axis=-1, keepdims=True)
    var = jnp.mean(jnp.square(o - mu), axis=-1, keepdims=True)
    o = ((o - mu) * lax.rsqrt(var + GN_EPS)).reshape(b, t, RET_HEADS * RET_V_DIM)
    o = (o * gn_w.astype(jnp.float32)).astype(h_v.dtype)
    return jax.nn.silu(h_g) * o


def hybrid_layer(x, ffn1_norm, ffn1_w1, ffn1_w3, ffn1_w2, mix_norm, w_in, dsa_kv_norm, dsa_w_uk,
                 dsa_w_uv, fox_f_bias, ret_gn_w, w_branch, w_out, ffn2_norm, ffn2_w1, ffn2_w3,
                 ffn2_w2, t5_table, topk):
    b, t = x.shape[:2]
    x = x + 0.5 * swiglu(rmsnorm(x, ffn1_norm), ffn1_w1, ffn1_w3, ffn1_w2)
    h = rmsnorm(x, mix_norm)
    (dq, dc, iq, ik, iw, fq, fk, fv, ff, rq, rk, rv, rg, gates) = split_cols(h @ w_in)
    branches = (
        dsa_branch(dq, dc, iq, ik, iw, dsa_kv_norm, dsa_w_uk, dsa_w_uv, t5_table, topk),
        fox_branch(fq, fk, fv, ff, fox_f_bias),
        retention_branch(rq, rk, rv, rg, ret_gn_w),
    )
    gates = jax.nn.sigmoid(gates.reshape(b, t, N_BRANCH, D_MODEL))
    merged = gates[:, :, 0] * (branches[0] @ w_branch[0])
    for j in range(1, N_BRANCH):
        merged = merged + gates[:, :, j] * (branches[j] @ w_branch[j])
    x = x + merged @ w_out
    x = x + 0.5 * swiglu(rmsnorm(x, ffn2_norm), ffn2_w1, ffn2_w3, ffn2_w2)
    return x


def setup_inputs(seed: int = 0) -> dict:
    key = jax.random.key(seed)
    ks = jax.random.split(key, 21)
    f32 = jnp.float32

    def nrm(k, shape, scale):
        return jax.random.normal(k, shape, f32) * scale

    def gain(k, shape):
        return 1.0 + 0.02 * jax.random.normal(k, shape, f32)

    return {
        "x": nrm(ks[0], (BATCH, SEQ, D_MODEL), 1.0),
        "meta_tokens": nrm(ks[1], (N_META, D_MODEL), 1.0),
        "t5_table": nrm(ks[2], (T5_BUCKETS, DSA_HEADS), 0.3),
        "ffn1_norm": gain(ks[3], (DEPTH, D_MODEL)),
        "ffn1_w1": nrm(ks[4], (DEPTH, D_MODEL, D_FF), D_MODEL ** -0.5),
        "ffn1_w3": nrm(ks[5], (DEPTH, D_MODEL, D_FF), D_MODEL ** -0.5),
        "ffn1_w2": nrm(ks[6], (DEPTH, D_FF, D_MODEL), D_FF ** -0.5),
        "mix_norm": gain(ks[7], (DEPTH, D_MODEL)),
        "w_in": nrm(ks[8], (DEPTH, D_MODEL, D_IN), D_MODEL ** -0.5),
        "dsa_kv_norm": gain(ks[9], (DEPTH, DSA_LATENT)),
        "dsa_w_uk": nrm(ks[10], (DEPTH, DSA_LATENT, DSA_HEADS, DSA_HEAD_DIM), DSA_LATENT ** -0.5),
        "dsa_w_uv": nrm(ks[11], (DEPTH, DSA_LATENT, DSA_HEADS, DSA_HEAD_DIM), DSA_LATENT ** -0.5),
        "fox_f_bias": 2.0 + 0.5 * jax.random.normal(ks[12], (DEPTH, FOX_HEADS), f32),
        "ret_gn_w": gain(ks[13], (DEPTH, RET_HEADS * RET_V_DIM)),
        "w_branch": nrm(ks[14], (DEPTH, N_BRANCH, BRANCH_WIDTH, D_MODEL), BRANCH_WIDTH ** -0.5),
        "w_out": nrm(ks[15], (DEPTH, D_MODEL, D_MODEL), D_MODEL ** -0.5),
        "ffn2_norm": gain(ks[16], (DEPTH, D_MODEL)),
        "ffn2_w1": nrm(ks[17], (DEPTH, D_MODEL, D_FF), D_MODEL ** -0.5),
        "ffn2_w3": nrm(ks[18], (DEPTH, D_MODEL, D_FF), D_MODEL ** -0.5),
        "ffn2_w2": nrm(ks[19], (DEPTH, D_FF, D_MODEL), D_FF ** -0.5),
        "final_norm": gain(ks[20], (D_MODEL,)),
    }


def reference(x, meta_tokens, t5_table, ffn1_norm, ffn1_w1, ffn1_w3, ffn1_w2, mix_norm, w_in,
              dsa_kv_norm, dsa_w_uk, dsa_w_uv, fox_f_bias, ret_gn_w, w_branch, w_out, ffn2_norm,
              ffn2_w1, ffn2_w3, ffn2_w2, final_norm):
    b, seq = x.shape[:2]
    topk = min(INDEX_TOPK, seq // 4)
    h = jnp.concatenate([
        jnp.zeros((b, PAD, D_MODEL), x.dtype),
        jnp.broadcast_to(meta_tokens.astype(x.dtype)[None], (b, N_META, D_MODEL)),
        x,
    ], axis=1)
    for l in range(DEPTH):
        h = hybrid_layer(h, ffn1_norm[l], ffn1_w1[l], ffn1_w3[l], ffn1_w2[l], mix_norm[l], w_in[l],
                         dsa_kv_norm[l], dsa_w_uk[l], dsa_w_uv[l], fox_f_bias[l], ret_gn_w[l],
                         w_branch[l], w_out[l], ffn2_norm[l], ffn2_w1[l], ffn2_w3[l], ffn2_w2[l],
                         t5_table, topk)
    return rmsnorm(h, final_norm)[:, BLOCK:]
```

```cpp
#include <hip/hip_runtime.h>
#include <hip/hip_cooperative_groups.h>
#include <cstdio>
#include <cstdint>
namespace cg = cooperative_groups;

typedef unsigned short bf16_t;
typedef short bf16x8 __attribute__((ext_vector_type(8)));
typedef float f32x16 __attribute__((ext_vector_type(16)));
typedef float f32x4 __attribute__((ext_vector_type(4)));
#define DEV __device__ __forceinline__

constexpr int T_ = 8320, M_ = 16640, D_ = 2048, DFF = 5632, NCH = 65, PAD_ = 112, SEQ_ = 8192;
constexpr int DIN = 14680;
constexpr int LDP = 7424, LDB = 4096;
constexpr int NIN = 9728;
constexpr int GS = 144;
constexpr int TILE_B = 128 * GS;
constexpr int LDS_BYTES = 4 * TILE_B;

struct Params {
  const float *x, *meta, *t5, *ffn1_norm, *ffn1_w1, *ffn1_w3, *ffn1_w2, *mix_norm, *w_in, *kv_norm, *w_uk, *w_uv,
      *f_bias, *gn_w, *w_branch, *w_out, *ffn2_norm, *ffn2_w1, *ffn2_w3, *ffn2_w2, *final_norm;
  float* out;
  bf16_t *W13, *W2t, *Wint, *Wgt, *Wb0, *Wb1, *Wb2, *Wot;
  float* X;
  bf16_t *H, *PROJ, *HID, *MERGED, *BR, *FVT, *RKT, *RVT, *CN, *IK16;
  float *SMALL, *CUM, *KV, *ST, *ROPE, *QN, *KN;
  int* IDX;
  int* NIDX;
  bf16_t* STASH;
  unsigned* CNT;
};

DEV float fexp2(float x) { return __builtin_amdgcn_exp2f(x); }
DEV int tid_() { int t = threadIdx.x; asm volatile("" : "+v"(t)); return t; }
DEV int bid_() { int b = blockIdx.x; asm volatile("" : "+s"(b)); return b; }
typedef __bf16 bf16x2_t __attribute__((ext_vector_type(2)));
typedef float f32x2_t __attribute__((ext_vector_type(2)));
DEV unsigned pk_bf16(float lo, float hi) {
  f32x2_t f = {lo, hi};
  bf16x2_t b = __builtin_convertvector(f, bf16x2_t);
  return __builtin_bit_cast(unsigned, b);
}
DEV float bf2f(unsigned v) { return __uint_as_float(v << 16); }
DEV float bflo(unsigned v) { return __uint_as_float(v << 16); }
DEV float bfhi(unsigned v) { return __uint_as_float(v & 0xffff0000u); }

template <class ColFn>
DEV void conv_t(bf16_t* __restrict__ dst, int nrows, int K, ColFn colfn, char* ldsraw) {
  float (*tl)[68] = (float (*)[68])ldsraw;
  const int tid = tid_();
  const int tk = K / 64, ntile = (nrows / 64) * tk;
  for (int u = bid_(); u < ntile; u += gridDim.x) {
    const int n0 = (u / tk) * 64, k0 = (u % tk) * 64;
    {
      const int n4 = (tid & 15) * 4, kb = tid >> 4;
      long ld; const float* col = colfn(n0 + n4, ld);
#pragma unroll
      for (int i = 0; i < 4; ++i) {
        const int kl = kb + 16 * i;
        const f32x4 v = col ? *(const f32x4*)(col + (long)(k0 + kl) * ld) : (f32x4){0.f, 0.f, 0.f, 0.f};
        *(f32x4*)&tl[kl][n4] = v;
      }
    }
    __syncthreads();
    {
      const int row = tid >> 2, kc = (tid & 3) * 16;
      unsigned w[8];
#pragma unroll
      for (int j = 0; j < 8; ++j) w[j] = pk_bf16(tl[kc + 2 * j][row], tl[kc + 2 * j + 1][row]);
      uint4* d = (uint4*)(dst + (long)(n0 + row) * K + k0 + kc);
      d[0] = make_uint4(w[0], w[1], w[2], w[3]);
      d[1] = make_uint4(w[4], w[5], w[6], w[7]);
    }
    __syncthreads();
  }
}

constexpr int GT_B = 128 * 128;
DEV void gemm_kloop(const bf16_t* __restrict__ Wp, long ldw, const bf16_t* __restrict__ Xp, long ldx, int K,
                    f32x16 (&acc)[2][2], char* lds) {
  const int tid = tid_(), lane = tid & 63, wid = tid >> 6, wr = wid >> 1, wc = wid & 1;
  const int r = lane & 31, hh = lane >> 5;
  const int srow = tid >> 3, sc = (tid & 7) ^ ((tid >> 4) & 7);
  const bf16_t* wsrc = Wp + (long)srow * ldw + sc * 8;
  const bf16_t* xsrc = Xp + (long)srow * ldx + sc * 8;
  typedef __attribute__((address_space(3))) unsigned lds_u32;
  typedef const __attribute__((address_space(1))) unsigned glb_u32;
#define G_DMA(buf, ko)                                                                                         \
  {                                                                                                            \
    char* _d = (buf) + tid * 16;                                                                               \
    __builtin_amdgcn_global_load_lds((glb_u32*)(wsrc + (ko)), (lds_u32*)(_d), 16, 0, 0);                       \
    __builtin_amdgcn_global_load_lds((glb_u32*)(wsrc + (long)32 * ldw + (ko)), (lds_u32*)(_d + 4096), 16, 0, 0);   \
    __builtin_amdgcn_global_load_lds((glb_u32*)(wsrc + (long)64 * ldw + (ko)), (lds_u32*)(_d + 8192), 16, 0, 0);   \
    __builtin_amdgcn_global_load_lds((glb_u32*)(wsrc + (long)96 * ldw + (ko)), (lds_u32*)(_d + 12288), 16, 0, 0);  \
    __builtin_amdgcn_global_load_lds((glb_u32*)(xsrc + (ko)), (lds_u32*)(_d + GT_B), 16, 0, 0);                \
    __builtin_amdgcn_global_load_lds((glb_u32*)(xsrc + (long)32 * ldx + (ko)), (lds_u32*)(_d + GT_B + 4096), 16, 0, 0);  \
    __builtin_amdgcn_global_load_lds((glb_u32*)(xsrc + (long)64 * ldx + (ko)), (lds_u32*)(_d + GT_B + 8192), 16, 0, 0);  \
    __builtin_amdgcn_global_load_lds((glb_u32*)(xsrc + (long)96 * ldx + (ko)), (lds_u32*)(_d + GT_B + 12288), 16, 0, 0); \
  }
  const int swz = (r >> 1) & 7;
  const int aoff = (wr * 64 + r) * 128;
  const int boff = GT_B + (wc * 64 + r) * 128;
  const int c0 = ((0 + hh) ^ swz) << 4, c1 = ((2 + hh) ^ swz) << 4, c2 = ((4 + hh) ^ swz) << 4, c3 = ((6 + hh) ^ swz) << 4;
#define G_FRAGS(cur, co, A0, A1, B0, B1)                                                             \
  A0 = *(const bf16x8*)((cur) + aoff + (co));                                                        \
  A1 = *(const bf16x8*)((cur) + aoff + 32 * 128 + (co));                                             \
  B0 = *(const bf16x8*)((cur) + boff + (co));                                                        \
  B1 = *(const bf16x8*)((cur) + boff + 32 * 128 + (co));
#define G_MMA(A0, A1, B0, B1)                                                                        \
  acc[0][0] = __builtin_amdgcn_mfma_f32_32x32x16_bf16(A0, B0, acc[0][0], 0, 0, 0);                   \
  acc[0][1] = __builtin_amdgcn_mfma_f32_32x32x16_bf16(A0, B1, acc[0][1], 0, 0, 0);                   \
  acc[1][0] = __builtin_amdgcn_mfma_f32_32x32x16_bf16(A1, B0, acc[1][0], 0, 0, 0);                   \
  acc[1][1] = __builtin_amdgcn_mfma_f32_32x32x16_bf16(A1, B1, acc[1][1], 0, 0, 0);
#define G_COMPUTE(cur)                                                                               \
  {                                                                                                  \
    bf16x8 pa0, pa1, pb0, pb1, qa0, qa1, qb0, qb1;                                                   \
    G_FRAGS(cur, c0, pa0, pa1, pb0, pb1)                                                             \
    G_FRAGS(cur, c1, qa0, qa1, qb0, qb1)                                                             \
    __builtin_amdgcn_s_setprio(1);                                                                   \
    G_MMA(pa0, pa1, pb0, pb1)                                                                        \
    G_FRAGS(cur, c2, pa0, pa1, pb0, pb1)                                                             \
    G_MMA(qa0, qa1, qb0, qb1)                                                                        \
    G_FRAGS(cur, c3, qa0, qa1, qb0, qb1)                                                             \
    G_MMA(pa0, pa1, pb0, pb1)                                                                        \
    G_MMA(qa0, qa1, qb0, qb1)                                                                        \
    __builtin_amdgcn_sched_group_barrier(0x100, 8, 0);                                               \
    __builtin_amdgcn_sched_group_barrier(0x008, 4, 0);                                               \
    __builtin_amdgcn_sched_group_barrier(0x100, 4, 0);                                               \
    __builtin_amdgcn_sched_group_barrier(0x008, 4, 0);                                               \
    __builtin_amdgcn_sched_group_barrier(0x100, 4, 0);                                               \
    __builtin_amdgcn_sched_group_barrier(0x008, 8, 0);                                               \
    __builtin_amdgcn_s_setprio(0);                                                                   \
  }
  const int nk = K >> 6;
  char* buf0 = lds;
  char* buf1 = lds + 2 * GT_B;
  G_DMA(buf0, 0);
  __syncthreads();
  for (int kt = 0; kt < nk; kt += 2) {
    G_DMA(buf1, (kt + 1) * 64);
    G_COMPUTE(buf0);
    __syncthreads();
    if (kt + 2 < nk) G_DMA(buf0, (kt + 2) * 64);
    G_COMPUTE(buf1);
    __syncthreads();
  }
#undef G_DMA
#undef G_COMPUTE
#undef G_FRAGS
#undef G_MMA
}


constexpr int K2_ST = 24576;
DEV void gemm_kloop256(const bf16_t* __restrict__ Wp, long ldw, const bf16_t* __restrict__ Xp, long ldx, int K,
                       f32x16 (&acc)[4][2], char* lds) {
  const int tid = tid_(), lane = tid & 63, wid = tid >> 6, wr = wid >> 1, wc = wid & 1;
  const int r = lane & 31, hh = lane >> 5;
  const int srow = tid >> 2, sc = (tid & 3) ^ ((tid >> 4) & 3);
  const bf16_t* wsrc = Wp + (long)srow * ldw + sc * 8;
  const bf16_t* xsrc = Xp + (long)srow * ldx + sc * 8;
  typedef __attribute__((address_space(3))) unsigned lds_u32;
  typedef const __attribute__((address_space(1))) unsigned glb_u32;
  char* dbase = lds + tid * 16;
#define G2_DMA(slot_, ko)                                                                                          \
  {                                                                                                                \
    char* _d = dbase + (slot_) * K2_ST;                                                                            \
    __builtin_amdgcn_global_load_lds((glb_u32*)(wsrc + (ko)), (lds_u32*)(_d), 16, 0, 0);                           \
    __builtin_amdgcn_global_load_lds((glb_u32*)(wsrc + (long)64 * ldw + (ko)), (lds_u32*)(_d + 4096), 16, 0, 0);   \
    __builtin_amdgcn_global_load_lds((glb_u32*)(wsrc + (long)128 * ldw + (ko)), (lds_u32*)(_d + 8192), 16, 0, 0);  \
    __builtin_amdgcn_global_load_lds((glb_u32*)(wsrc + (long)192 * ldw + (ko)), (lds_u32*)(_d + 12288), 16, 0, 0); \
    __builtin_amdgcn_global_load_lds((glb_u32*)(xsrc + (ko)), (lds_u32*)(_d + 16384), 16, 0, 0);                   \
    __builtin_amdgcn_global_load_lds((glb_u32*)(xsrc + (long)64 * ldx + (ko)), (lds_u32*)(_d + 20480), 16, 0, 0);  \
  }
  const int swz = (r >> 2) & 3;
  const int aoff = (wr * 128 + r) * 64;
  const int boff = 16384 + (wc * 64 + r) * 64;
  const int c0 = ((0 + hh) ^ swz) << 4, c1 = ((2 + hh) ^ swz) << 4;
#define G2_KK(cur, ck)                                                                               \
  {                                                                                                  \
    const bf16x8 a0 = *(const bf16x8*)((cur) + aoff + (ck));                                         \
    const bf16x8 a1 = *(const bf16x8*)((cur) + aoff + 2048 + (ck));                                  \
    const bf16x8 a2 = *(const bf16x8*)((cur) + aoff + 4096 + (ck));                                  \
    const bf16x8 a3 = *(const bf16x8*)((cur) + aoff + 6144 + (ck));                                  \
    const bf16x8 b0 = *(const bf16x8*)((cur) + boff + (ck));                                         \
    const bf16x8 b1 = *(const bf16x8*)((cur) + boff + 2048 + (ck));                                  \
    acc[0][0] = __builtin_amdgcn_mfma_f32_32x32x16_bf16(a0, b0, acc[0][0], 0, 0, 0);                 \
    acc[0][1] = __builtin_amdgcn_mfma_f32_32x32x16_bf16(a0, b1, acc[0][1], 0, 0, 0);                 \
    acc[1][0] = __builtin_amdgcn_mfma_f32_32x32x16_bf16(a1, b0, acc[1][0], 0, 0, 0);                 \
    acc[1][1] = __builtin_amdgcn_mfma_f32_32x32x16_bf16(a1, b1, acc[1][1], 0, 0, 0);                 \
    acc[2][0] = __builtin_amdgcn_mfma_f32_32x32x16_bf16(a2, b0, acc[2][0], 0, 0, 0);                 \
    acc[2][1] = __builtin_amdgcn_mfma_f32_32x32x16_bf16(a2, b1, acc[2][1], 0, 0, 0);                 \
    acc[3][0] = __builtin_amdgcn_mfma_f32_32x32x16_bf16(a3, b0, acc[3][0], 0, 0, 0);                 \
    acc[3][1] = __builtin_amdgcn_mfma_f32_32x32x16_bf16(a3, b1, acc[3][1], 0, 0, 0);                 \
  }
#define G2_SYNC()                                                  \
  asm volatile("s_waitcnt vmcnt(6) lgkmcnt(0)" ::: "memory");      \
  __builtin_amdgcn_s_barrier();                                    \
  asm volatile("" ::: "memory");
  const int n = K >> 5;
  const int klast = (n - 1) * 32;
  G2_DMA(0, 0);
  G2_DMA(1, 32);
  G2_SYNC();
  int slot = 0;
  for (int s = 0; s < n; ++s) {
    const int dslot = slot >= 1 ? slot - 1 : 2;
    const int k2 = (s + 2) * 32;
    G2_DMA(dslot, k2 < klast ? k2 : klast);
    const char* cur = lds + slot * K2_ST;
    __builtin_amdgcn_s_setprio(1);
    G2_KK(cur, c0);
    G2_KK(cur, c1);
    __builtin_amdgcn_s_setprio(0);
    G2_SYNC();
    slot = slot == 2 ? 0 : slot + 1;
  }
  asm volatile("s_waitcnt vmcnt(0)" ::: "memory");
  __builtin_amdgcn_s_barrier();
  asm volatile("" ::: "memory");
#undef G2_DMA
#undef G2_KK
#undef G2_SYNC
}

DEV void zero_acc4(f32x16 (&acc)[4][2]) {
#pragma unroll
  for (int a = 0; a < 4; ++a)
#pragma unroll
    for (int b = 0; b < 2; ++b)
#pragma unroll
      for (int i = 0; i < 16; ++i) acc[a][b][i] = 0.f;
}

DEV bool tile_coords(int L, int nM, int nN, int& pm, int& pn) {
  if (L >= nM * nN) return false;
  const int nig = 8 * nN, gid = L / nig, fm = gid * 8, gsz = (nM - fm) < 8 ? (nM - fm) : 8;
  pm = fm + (L % nig) % gsz;
  pn = (L % nig) / gsz;
  return true;
}
#define TILE_LOOP(nM, nN)                                                                   \
  for (int _it = 0, _nb = gridDim.x >> 3, _x = bid_() & 7, _j = bid_() >> 3, pm, pn; \
       tile_coords((_it * 8 + _x) * _nb + _j, (nM), (nN), pm, pn); ++_it)

DEV void zero_acc(f32x16 (&acc)[2][2]) {
#pragma unroll
  for (int a = 0; a < 2; ++a)
#pragma unroll
    for (int b = 0; b < 2; ++b)
#pragma unroll
      for (int i = 0; i < 16; ++i) acc[a][b][i] = 0.f;
}

DEV void norm_phase(const Params& p, const float* __restrict__ g, bf16_t* __restrict__ Hout, int mode) {
  const int lane = tid_() & 63;
  const int gw = (bid_() * blockDim.x + tid_()) >> 6, nw = (gridDim.x * blockDim.x) >> 6;
  for (int row = gw; row < M_; row += nw) {
    const int b = row / T_, t = row % T_;
    const float* src;
    if (mode == 0) src = p.X + (long)row * D_;
    else src = (t < PAD_) ? nullptr : (t < 128 ? p.meta + (long)(t - PAD_) * D_ : p.x + ((long)b * SEQ_ + (t - 128)) * D_);
    f32x4 v[8];
    float ss = 0.f;
#pragma unroll
    for (int i = 0; i < 8; ++i) {
      v[i] = src ? *(const f32x4*)(src + i * 256 + lane * 4) : (f32x4){0.f, 0.f, 0.f, 0.f};
      ss += v[i][0] * v[i][0] + v[i][1] * v[i][1] + v[i][2] * v[i][2] + v[i][3] * v[i][3];
    }
#pragma unroll
    for (int o = 32; o > 0; o >>= 1) ss += __shfl_xor(ss, o);
    const float rs = rsqrtf(ss * (1.0f / D_) + 1e-6f);
#pragma unroll
    for (int i = 0; i < 8; ++i) {
      const f32x4 gg = *(const f32x4*)(g + i * 256 + lane * 4);
      if (mode == 1) *(f32x4*)(p.X + (long)row * D_ + i * 256 + lane * 4) = v[i];
      uint2 o;
      o.x = pk_bf16(v[i][0] * rs * gg[0], v[i][1] * rs * gg[1]);
      o.y = pk_bf16(v[i][2] * rs * gg[2], v[i][3] * rs * gg[3]);
      *(uint2*)(Hout + (long)row * D_ + i * 256 + lane * 4) = o;
    }
  }
}

DEV void final_norm_phase(const Params& p) {
  const int lane = tid_() & 63;
  const int gw = (bid_() * blockDim.x + tid_()) >> 6, nw = (gridDim.x * blockDim.x) >> 6;
  for (int orow = gw; orow < 2 * SEQ_; orow += nw) {
    const int b = orow / SEQ_, t = orow % SEQ_;
    const float* src = p.X + ((long)b * T_ + 128 + t) * D_;
    f32x4 v[8];
    float ss = 0.f;
#pragma unroll
    for (int i = 0; i < 8; ++i) {
      v[i] = *(const f32x4*)(src + i * 256 + lane * 4);
      ss += v[i][0] * v[i][0] + v[i][1] * v[i][1] + v[i][2] * v[i][2] + v[i][3] * v[i][3];
    }
#pragma unroll
    for (int o = 32; o > 0; o >>= 1) ss += __shfl_xor(ss, o);
    const float rs = rsqrtf(ss * (1.0f / D_) + 1e-6f);
#pragma unroll
    for (int i = 0; i < 8; ++i) {
      const f32x4 gg = *(const f32x4*)(p.final_norm + i * 256 + lane * 4);
      f32x4 o = {v[i][0] * rs * gg[0], v[i][1] * rs * gg[1], v[i][2] * rs * gg[2], v[i][3] * rs * gg[3]};
      *(f32x4*)(p.out + (long)orow * D_ + i * 256 + lane * 4) = o;
    }
  }
}

DEV void conv_ffn(const Params& p, const float* w1, const float* w3, const float* w2, char* lds) {
  conv_t(p.W13, 2 * DFF, D_, [=](int n, long& ld) -> const float* {
    ld = DFF;
    const int tile = n >> 7, o = n & 127, wr = o >> 6, sub = (o & 63) >> 5, f = tile * 64 + wr * 32 + (o & 31);
    return (sub ? w3 : w1) + f;
  }, lds);
  conv_t(p.W2t, D_, DFF, [=](int n, long& ld) -> const float* { ld = D_; return w2 + n; }, lds);
}

DEV void ffn_up_phase(const Params& p, char* lds) {
  const int lane = tid_() & 63, wid = tid_() >> 6, wr = wid >> 1, wc = wid & 1, r = lane & 31, hh = lane >> 5;
  constexpr int ES = 144;
  char* stg = lds + wid * (64 * ES);
  TILE_LOOP(130, 44) {
    f32x16 acc[4][2];
    zero_acc4(acc);
    gemm_kloop256(p.W13 + (long)pn * 256 * D_, D_, p.H + (long)pm * 128 * D_, D_, D_, acc, lds);
    const int grp = pn * 2 + wr;
#pragma unroll
    for (int ni = 0; ni < 2; ++ni)
#pragma unroll
      for (int hp = 0; hp < 2; ++hp)
#pragma unroll
        for (int q = 0; q < 4; ++q) {
          float o[4];
#pragma unroll
          for (int e = 0; e < 4; ++e) {
            const float gte = acc[2 * hp][ni][4 * q + e], up = acc[2 * hp + 1][ni][4 * q + e];
            o[e] = gte / (1.f + __expf(-gte)) * up;
          }
          uint2 w;
          w.x = pk_bf16(o[0], o[1]);
          w.y = pk_bf16(o[2], o[3]);
          *(uint2*)(stg + (ni * 32 + r) * ES + (hp * 32 + 8 * q + 4 * hh) * 2) = w;
        }
    asm volatile("s_waitcnt lgkmcnt(0)" ::: "memory");
    {
      const int trow = lane >> 3, ch = lane & 7;
      bf16_t* dst = p.HID + ((long)pm * 128 + wc * 64 + trow) * DFF + grp * 64 + ch * 8;
#pragma unroll
      for (int i = 0; i < 8; ++i) {
        const uint4 v = *(const uint4*)(stg + (trow + 8 * i) * ES + ch * 16);
        *(uint4*)(dst + (long)(8 * i) * DFF) = v;
      }
    }
    __syncthreads();
  }
}

DEV void resid_gemm_phase(const Params& p, const bf16_t* Wt, const bf16_t* A, int K, float alpha, char* lds) {
  const int lane = tid_() & 63, wid = tid_() >> 6, wr = wid >> 1, wc = wid & 1, r = lane & 31, hh = lane >> 5;
  TILE_LOOP(130, 16) {
    f32x16 acc[2][2];
    zero_acc(acc);
    gemm_kloop(Wt + (long)pn * 128 * K, K, A + (long)pm * 128 * K, K, K, acc, lds);
    {
      constexpr int RS = 272;
      char* stg = lds + wid * (64 * RS);
#pragma unroll
      for (int mi = 0; mi < 2; ++mi)
#pragma unroll
        for (int ni = 0; ni < 2; ++ni)
#pragma unroll
          for (int q = 0; q < 4; ++q)
            *(f32x4*)(stg + (ni * 32 + r) * RS + (mi * 32 + 8 * q + 4 * hh) * 4) =
                (f32x4){acc[mi][ni][4 * q], acc[mi][ni][4 * q + 1], acc[mi][ni][4 * q + 2], acc[mi][ni][4 * q + 3]};
      asm volatile("s_waitcnt lgkmcnt(0)" ::: "memory");
      const int trow = lane >> 4, ch = lane & 15;
      float* xp = p.X + ((long)pm * 128 + wc * 64 + trow) * D_ + pn * 128 + wr * 64 + ch * 4;
#pragma unroll
      for (int i = 0; i < 16; ++i) {
        const f32x4 u = *(const f32x4*)(stg + (trow + 4 * i) * RS + ch * 16);
        f32x4* px = (f32x4*)(xp + (long)(4 * i) * D_);
        f32x4 v = *px;
        v += alpha * u;
        *px = v;
      }
      __syncthreads();
    }
  }
}


DEV void fold_phase(const Params& p, int l, int mode, char* ldsraw) {
  float (*P)[129] = (float (*)[129])ldsraw;
  float (*Q)[129] = (float (*)[129])(ldsraw + 64 * 129 * 4);
  const int tid = tid_();
  const float* w_in = p.w_in + (long)l * D_ * DIN;
  const float* w_uk = p.w_uk + (long)l * 256 * 1024;
  const float* w_uv = p.w_uv + (long)l * 256 * 1024;
  const float* wb0 = p.w_branch + (long)l * 3 * 1024 * D_;
  const int nI = mode == 0 ? 4 : 32, nJ = mode == 0 ? 32 : 4;
  for (int u = bid_(); u < 8 * nI * nJ; u += gridDim.x) {
    const int h = u / (nI * nJ), i0 = ((u / nJ) % nI) * 64, j0 = (u % nJ) * 64;
    if (mode == 0) {
      const int d = tid & 127, rb = tid >> 7;
#pragma unroll 4
      for (int it = 0; it < 32; ++it) {
        const int row = rb + 2 * it;
        P[row][d] = w_uk[((long)(i0 + row) * 8 + h) * 128 + d];
        Q[row][d] = w_in[(long)(j0 + row) * DIN + h * 128 + d];
      }
    } else {
      const int d = tid & 127, rb = tid >> 7;
#pragma unroll 4
      for (int it = 0; it < 32; ++it) {
        const int row = rb + 2 * it;
        Q[row][d] = w_uv[((long)(j0 + row) * 8 + h) * 128 + d];
      }
      const int ii = tid & 63, db = tid >> 6;
#pragma unroll 4
      for (int it = 0; it < 32; ++it) {
        const int dd = db + 4 * it;
        P[ii][dd] = wb0[(long)(h * 128 + dd) * D_ + i0 + ii];
      }
    }
    __syncthreads();
    const int ti = tid >> 4, tj = tid & 15;
    float o[4][4];
#pragma unroll
    for (int a = 0; a < 4; ++a)
#pragma unroll
      for (int b = 0; b < 4; ++b) o[a][b] = 0.f;
#pragma unroll 4
    for (int d = 0; d < 128; ++d) {
      float pa[4], qb[4];
#pragma unroll
      for (int a = 0; a < 4; ++a) { pa[a] = P[ti * 4 + a][d]; qb[a] = Q[tj * 4 + a][d]; }
#pragma unroll
      for (int a = 0; a < 4; ++a)
#pragma unroll
        for (int b = 0; b < 4; ++b) o[a][b] += pa[a] * qb[b];
    }
    const float sc = mode == 0 ? 0.08838834764831845f * 1.4426950408889634f : 1.0f;
#pragma unroll
    for (int a = 0; a < 4; ++a) {
      uint2 w;
      w.x = pk_bf16(o[a][0] * sc, o[a][1] * sc);
      w.y = pk_bf16(o[a][2] * sc, o[a][3] * sc);
      if (mode == 0) *(uint2*)(p.Wint + (long)(h * 256 + i0 + ti * 4 + a) * D_ + j0 + tj * 4) = w;
      else *(uint2*)(p.Wb0 + (long)(i0 + ti * 4 + a) * 2048 + h * 256 + j0 + tj * 4) = w;
    }
    __syncthreads();
  }
}

DEV void conv_mixer(const Params& p, int l, char* lds) {
  const float* w_in = p.w_in + (long)l * D_ * DIN;
  fold_phase(p, l, 0, lds);
  fold_phase(p, l, 1, lds);
  conv_t(p.Wint + (long)2048 * D_, NIN - 2048, D_, [=](int n, long& ld) -> const float* {
    ld = DIN;
    n += 2048;
    int c;
    if (n < 2304) c = 1024 + (n - 2048);
    else if (n < 3328) c = 1280 + (n - 2304);
    else if (n < 3456) { const int o = n - 3328; c = o < 64 ? 2304 + o : (o < 80 ? 2368 + (o - 64) : (o < 88 ? 5456 + (o - 80) : -1)); }
    else if (n < 4480) c = 2384 + (n - 3456);
    else if (n < 5504) c = 3408 + (n - 4480);
    else if (n < 6528) c = 4432 + (n - 5504);
    else if (n < 7040) c = 5464 + (n - 6528);
    else if (n < 7552) c = 5976 + (n - 7040);
    else if (n < 8576) c = 6488 + (n - 7552);
    else if (n < 9600) c = 7512 + (n - 8576);
    else c = -1;
    return c < 0 ? nullptr : w_in + c;
  }, lds);
  conv_t(p.Wgt, 6144, D_, [=](int n, long& ld) -> const float* { ld = DIN; return w_in + 8536 + n; }, lds);
  const float* wb = p.w_branch + (long)l * 3 * 1024 * D_;
  conv_t(p.Wb1, D_, 1024, [=](int n, long& ld) -> const float* { ld = D_; return wb + (long)1024 * D_ + n; }, lds);
  conv_t(p.Wb2, D_, 1024, [=](int n, long& ld) -> const float* { ld = D_; return wb + (long)2 * 1024 * D_ + n; }, lds);
  const float* wo = p.w_out + (long)l * D_ * D_;
  conv_t(p.Wot, D_, D_, [=](int n, long& ld) -> const float* { ld = D_; return wo + n; }, lds);
}

DEV void rope_table_phase(const Params& p) {
  const int gt = bid_() * blockDim.x + tid_(), nt = gridDim.x * blockDim.x;
  for (int e = gt; e < T_ * 32; e += nt) {
    const int t = e >> 5, i = e & 31;
    const float inv = fexp2(-(float)i * (13.287712379549449f / 32.0f));
    const float ang = (float)t * inv;
    const float k = rintf(ang * 0.15915494309189535f);
    float rr = fmaf(-k, 6.28318548202514648f, ang);
    rr = fmaf(-k, -1.74845553146951715e-07f, rr);
    p.ROPE[t * 64 + i] = __cosf(rr);
    p.ROPE[t * 64 + 32 + i] = __sinf(rr);
  }
}

DEV void proj_phase(const Params& p, char* lds) {
  const int lane = tid_() & 63, wid = tid_() >> 6, wr = wid >> 1, wc = wid & 1, r = lane & 31, hh = lane >> 5;
  TILE_LOOP(130, 38) {
    f32x16 acc[4][2];
    zero_acc4(acc);
    gemm_kloop256(p.Wint + (long)pn * 256 * D_, D_, p.H + (long)pm * 128 * D_, D_, D_, acc, lds);
    const int sn = pn * 2 + wr;
    const bool plain = sn < 26 || (sn >= 27 && sn <= 42) || (sn >= 67 && sn <= 74);
    if (plain) {
      int col; float sc = 1.f;
      if (sn < 16) col = sn * 128;
      else if (sn < 18) col = 2048 + (sn - 16) * 128;
      else if (sn < 26) { col = 2304 + (sn - 18) * 128; sc = 0.125f; }
      else if (sn < 35) { col = 3328 + (sn - 27) * 128; sc = 0.08838834764831845f * 1.4426950408889634f; }
      else if (sn < 43) col = 4352 + (sn - 35) * 128;
      else col = 6400 + (sn - 67) * 128;
      constexpr int PS = 272;
      char* stg = lds + wid * (64 * PS);
#pragma unroll
      for (int mi = 0; mi < 4; ++mi)
#pragma unroll
        for (int ni = 0; ni < 2; ++ni)
#pragma unroll
          for (int q = 0; q < 4; ++q) {
            uint2 w;
            w.x = pk_bf16(acc[mi][ni][4 * q] * sc, acc[mi][ni][4 * q + 1] * sc);
            w.y = pk_bf16(acc[mi][ni][4 * q + 2] * sc, acc[mi][ni][4 * q + 3] * sc);
            *(uint2*)(stg + (ni * 32 + r) * PS + (mi * 32 + 8 * q + 4 * hh) * 2) = w;
          }
      asm volatile("s_waitcnt lgkmcnt(0)" ::: "memory");
      const int trow = lane >> 4, ch = lane & 15;
      bf16_t* dst = p.PROJ + ((long)pm * 128 + wc * 64 + trow) * LDP + col + ch * 8;
#pragma unroll
      for (int i = 0; i < 16; ++i) *(uint4*)(dst + (long)(4 * i) * LDP) = *(const uint4*)(stg + (trow + 4 * i) * PS + ch * 16);
    } else if ((sn >= 43 && sn <= 50) || (sn >= 59 && sn <= 66)) {
      typedef short s16x4_t __attribute__((ext_vector_type(4)));
      typedef __attribute__((address_space(3))) s16x4_t* lds_s16x4;
      constexpr int PS = 272;
      char* stg = lds + wid * (64 * PS);
#pragma unroll
      for (int mi = 0; mi < 4; ++mi)
#pragma unroll
        for (int ni = 0; ni < 2; ++ni)
#pragma unroll
          for (int q = 0; q < 4; ++q) {
            uint2 w;
            w.x = pk_bf16(acc[mi][ni][4 * q], acc[mi][ni][4 * q + 1]);
            w.y = pk_bf16(acc[mi][ni][4 * q + 2], acc[mi][ni][4 * q + 3]);
            *(uint2*)(stg + (ni * 32 + r) * PS + (mi * 32 + 8 * q + 4 * hh) * 2) = w;
          }
      asm volatile("s_waitcnt lgkmcnt(0)" ::: "memory");
      const bool isf = sn <= 50;
      const int hd = isf ? sn - 43 : sn - 59;
      const long tok0 = (long)pm * 128 + wc * 64;
      const int b = (int)(tok0 / T_), t0 = (int)(tok0 % T_);
      bf16_t* obase = (isf ? p.FVT : p.RVT) + ((long)(b * 8 + hd) * 128) * T_ + t0;
      const int g = lane >> 4, i16 = lane & 15, qq = i16 >> 2, pp = i16 & 3;
#pragma unroll
      for (int fb = 0; fb < 8; ++fb)
#pragma unroll
        for (int j = 0; j < 2; ++j) {
          const int r0 = (g + 4 * j) * 8, c0 = fb * 16;
          const char* a0 = stg + (r0 + qq) * PS + (c0 + 4 * pp) * 2;
          const s16x4_t lo = __builtin_amdgcn_ds_read_tr16_b64_v4i16((lds_s16x4)a0);
          const s16x4_t hi = __builtin_amdgcn_ds_read_tr16_b64_v4i16((lds_s16x4)(a0 + 4 * PS));
          union { uint4 u; short h[8]; } o;
          o.h[0] = lo[0]; o.h[1] = lo[1]; o.h[2] = lo[2]; o.h[3] = lo[3];
          o.h[4] = hi[0]; o.h[5] = hi[1]; o.h[6] = hi[2]; o.h[7] = hi[3];
          *(uint4*)(obase + (long)(c0 + i16) * T_ + r0) = o.u;
        }
    } else if (sn >= 75) {
    } else if (sn >= 51 && sn <= 58) {
      const bool isk = sn >= 55;
#pragma unroll
      for (int hs = 0; hs < 2; ++hs) {
        const int head = (isk ? sn - 55 : sn - 51) * 2 + hs;
#pragma unroll
        for (int ni = 0; ni < 2; ++ni) {
          const long tok = (long)pm * 128 + wc * 64 + ni * 32 + r;
          const int b = (int)(tok / T_), t = (int)(tok % T_);
          const float ksc = isk ? (t >= PAD_ ? 0.125f : 0.f) : 1.f;
#pragma unroll
          for (int q = 0; q < 4; ++q) {
            const int i = 8 * q + 4 * hh;
            const f32x4 cs = *(const f32x4*)(p.ROPE + t * 64 + i), sn4 = *(const f32x4*)(p.ROPE + t * 64 + 32 + i);
            float y1[4], y2[4];
#pragma unroll
            for (int e = 0; e < 4; ++e) {
              const float x1 = acc[2 * hs][ni][4 * q + e], x2 = acc[2 * hs + 1][ni][4 * q + e];
              y1[e] = (x1 * cs[e] - x2 * sn4[e]) * ksc;
              y2[e] = (x1 * sn4[e] + x2 * cs[e]) * ksc;
            }
            uint2 w1, w2;
            w1.x = pk_bf16(y1[0], y1[1]); w1.y = pk_bf16(y1[2], y1[3]);
            w2.x = pk_bf16(y2[0], y2[1]); w2.y = pk_bf16(y2[2], y2[3]);
            const int col = (isk ? 5888 : 5376) + head * 64 + i;
            *(uint2*)(p.PROJ + tok * LDP + col) = w1;
            *(uint2*)(p.PROJ + tok * LDP + col + 32) = w2;
            if (isk) {
              bf16_t* kt = p.RKT + ((long)(b * 8 + head) * 64 + i) * T_ + t;
              kt[0] = (bf16_t)(w1.x & 0xffff); kt[T_] = (bf16_t)(w1.x >> 16); kt[2 * T_] = (bf16_t)(w1.y & 0xffff); kt[3 * T_] = (bf16_t)(w1.y >> 16);
              kt[(long)32 * T_] = (bf16_t)(w2.x & 0xffff); kt[(long)33 * T_] = (bf16_t)(w2.x >> 16);
              kt[(long)34 * T_] = (bf16_t)(w2.y & 0xffff); kt[(long)35 * T_] = (bf16_t)(w2.y >> 16);
            }
          }
        }
      }
    } else {
#pragma unroll
      for (int mi = 0; mi < 4; ++mi)
#pragma unroll
        for (int ni = 0; ni < 2; ++ni) {
          const long tok = (long)pm * 128 + wc * 64 + ni * 32 + r;
          const int b = (int)(tok / T_), t = (int)(tok % T_);
#pragma unroll
          for (int q = 0; q < 4; ++q) {
            const int fl = mi * 32 + 8 * q + 4 * hh;
            float v[4];
#pragma unroll
            for (int e = 0; e < 4; ++e) v[e] = acc[mi][ni][4 * q + e];
            if (sn == 26) {
              *(f32x4*)(p.SMALL + tok * 128 + fl) = (f32x4){v[0], v[1], v[2], v[3]};
              if (fl < 64) { uint2 w; w.x = pk_bf16(v[0], v[1]); w.y = pk_bf16(v[2], v[3]); *(uint2*)(p.IK16 + tok * 64 + fl) = w; }
            } else if ((sn >= 43 && sn <= 50) || (sn >= 59 && sn <= 66)) {
              const bool isf = sn <= 50;
              const int hd = isf ? sn - 43 : sn - 59;
              bf16_t* dst = (isf ? p.FVT : p.RVT) + ((long)(b * 8 + hd) * 128 + fl) * T_ + t;
              const unsigned a = pk_bf16(v[0], v[1]), c = pk_bf16(v[2], v[3]);
              dst[0] = (bf16_t)(a & 0xffff); dst[T_] = (bf16_t)(a >> 16); dst[2 * T_] = (bf16_t)(c & 0xffff); dst[3 * T_] = (bf16_t)(c >> 16);
            } else {
              int col; float sc = 1.f;
              if (sn < 16) col = sn * 128;
              else if (sn < 18) col = 2048 + (sn - 16) * 128;
              else if (sn < 26) { col = 2304 + (sn - 18) * 128; sc = 0.125f; }
              else if (sn < 35) { col = 3328 + (sn - 27) * 128; sc = 0.08838834764831845f * 1.4426950408889634f; }
              else if (sn < 43) col = 4352 + (sn - 35) * 128;
              else col = 6400 + (sn - 67) * 128;
              uint2 w; w.x = pk_bf16(v[0] * sc, v[1] * sc); w.y = pk_bf16(v[2] * sc, v[3] * sc);
              *(uint2*)(p.PROJ + tok * LDP + col + fl) = w;
            }
          }
        }
    }
    __syncthreads();
  }
}

DEV bf16x8 ld_frag16(const bf16_t* ptr) { return *(const bf16x8*)ptr; }
DEV float log2gamma(int hd) { return __log2f(1.0f - fexp2(-5.0f - (float)hd)); }

DEV void ret_kv_phase(const Params& p) {
  const int lane = tid_() & 63, r = lane & 31, hh = lane >> 5;
  const int gw = (bid_() * blockDim.x + tid_()) >> 6, nw = (gridDim.x * blockDim.x) >> 6;
  for (int u = gw; u < 2 * NCH * 8 * 2; u += nw) {
    const int dvh = u & 1, hd = (u >> 1) & 7, n = (u >> 4) % NCH, b = u / (16 * NCH);
    const float lg = log2gamma(hd);
    f32x16 acc[2][2];
    zero_acc(acc);
    const bf16_t* vt = p.RVT + ((long)(b * 8 + hd) * 128 + dvh * 64 + r) * T_ + n * 128 + 8 * hh;
    const bf16_t* kt = p.RKT + ((long)(b * 8 + hd) * 64 + r) * T_ + n * 128 + 8 * hh;
#pragma unroll 2
    for (int ks = 0; ks < 8; ++ks) {
      const bf16x8 a0 = ld_frag16(vt + ks * 16), a1 = ld_frag16(vt + (long)32 * T_ + ks * 16);
      bf16x8 kb[2];
#pragma unroll
      for (int nt = 0; nt < 2; ++nt) {
        const uint4 raw = *(const uint4*)(kt + (long)nt * 32 * T_ + ks * 16);
        const unsigned rw[4] = {raw.x, raw.y, raw.z, raw.w};
        unsigned o[4];
#pragma unroll
        for (int e = 0; e < 4; ++e) {
          const int j = ks * 16 + 8 * hh + 2 * e;
          const float d0 = fexp2((float)(127 - j) * lg), d1 = fexp2((float)(126 - j) * lg);
          o[e] = pk_bf16(bflo(rw[e]) * d0, bfhi(rw[e]) * d1);
        }
        union { uint4 u; bf16x8 v; } cv; cv.u = make_uint4(o[0], o[1], o[2], o[3]);
        kb[nt] = cv.v;
      }
      acc[0][0] = __builtin_amdgcn_mfma_f32_32x32x16_bf16(a0, kb[0], acc[0][0], 0, 0, 0);
      acc[0][1] = __builtin_amdgcn_mfma_f32_32x32x16_bf16(a0, kb[1], acc[0][1], 0, 0, 0);
      acc[1][0] = __builtin_amdgcn_mfma_f32_32x32x16_bf16(a1, kb[0], acc[1][0], 0, 0, 0);
      acc[1][1] = __builtin_amdgcn_mfma_f32_32x32x16_bf16(a1, kb[1], acc[1][1], 0, 0, 0);
    }
    float* dst = p.KV + ((long)(n * 2 + b) * 8 + hd) * 8192;
#pragma unroll
    for (int mt = 0; mt < 2; ++mt)
#pragma unroll
      for (int nt = 0; nt < 2; ++nt)
#pragma unroll
        for (int reg = 0; reg < 16; ++reg) {
          const int dv = dvh * 64 + mt * 32 + (reg & 3) + 8 * (reg >> 2) + 4 * hh;
          dst[dv * 64 + nt * 32 + r] = acc[mt][nt][reg];
        }
  }
}

DEV void ret_scan_phase(const Params& p) {
  const int gt = bid_() * blockDim.x + tid_(), nt = gridDim.x * blockDim.x;
  for (int e = gt; e < 131072; e += nt) {
    const int hd = (e >> 13) & 7;
    const float cd = fexp2(128.0f * log2gamma(hd));
    float s = 0.f;
    float* base = p.KV + e;
    for (int n0 = 0; n0 < NCH; n0 += 13) {
      float v[13];
#pragma unroll
      for (int i = 0; i < 13; ++i) v[i] = base[(long)(n0 + i) * 131072];
#pragma unroll
      for (int i = 0; i < 13; ++i) { base[(long)(n0 + i) * 131072] = s; s = cd * s + v[i]; }
    }
  }
}

DEV void ret_out_phase(const Params& p, const float* gw_) {
  const int lane = tid_() & 63, r = lane & 31, hh = lane >> 5;
  const int gw = (bid_() * blockDim.x + tid_()) >> 6, nw = (gridDim.x * blockDim.x) >> 6;
  for (int u = gw; u < 2 * NCH * 8 * 4; u += nw) {
    const int w = u & 3, hd = (u >> 2) & 7, n = (u >> 5) % NCH, b = u / (32 * NCH);
    const float lg = log2gamma(hd);
    const long tok = (long)b * T_ + n * 128 + w * 32 + r;
    bf16x8 qf[4];
#pragma unroll
    for (int ks = 0; ks < 4; ++ks) qf[ks] = ld_frag16(p.PROJ + tok * LDP + 5376 + hd * 64 + ks * 16 + 8 * hh);
    f32x16 O[4];
#pragma unroll
    for (int mt = 0; mt < 4; ++mt)
#pragma unroll
      for (int i = 0; i < 16; ++i) O[mt][i] = 0.f;
    const float* st = p.ST + ((long)(n * 2 + b) * 8 + hd) * 8192;
#pragma unroll
    for (int mt = 0; mt < 4; ++mt)
#pragma unroll
      for (int ks = 0; ks < 4; ++ks) {
        const float* sp = st + (mt * 32 + r) * 64 + ks * 16 + 8 * hh;
        const f32x4 s0 = *(const f32x4*)sp, s1 = *(const f32x4*)(sp + 4);
        union { uint4 u; bf16x8 v; } cv;
        cv.u = make_uint4(pk_bf16(s0[0], s0[1]), pk_bf16(s0[2], s0[3]), pk_bf16(s1[0], s1[1]), pk_bf16(s1[2], s1[3]));
        O[mt] = __builtin_amdgcn_mfma_f32_32x32x16_bf16(cv.v, qf[ks], O[mt], 0, 0, 0);
      }
    {
      const float qd = fexp2((float)(w * 32 + r + 1) * lg);
#pragma unroll
      for (int mt = 0; mt < 4; ++mt)
#pragma unroll
        for (int i = 0; i < 16; ++i) O[mt][i] *= qd;
    }
    for (int jt = 0; jt <= w; ++jt) {
      f32x16 s;
#pragma unroll
      for (int i = 0; i < 16; ++i) s[i] = 0.f;
      const bf16_t* kp = p.PROJ + ((long)b * T_ + n * 128 + jt * 32 + r) * LDP + 5888 + hd * 64 + 8 * hh;
#pragma unroll
      for (int ks = 0; ks < 4; ++ks) s = __builtin_amdgcn_mfma_f32_32x32x16_bf16(ld_frag16(kp + ks * 16), qf[ks], s, 0, 0, 0);
      const int ii = w * 32 + r;
      unsigned pw[8];
#pragma unroll
      for (int e = 0; e < 8; ++e) {
        float v2[2];
#pragma unroll
        for (int z = 0; z < 2; ++z) {
          const int reg = 2 * e + z;
          const int j = jt * 32 + (reg & 3) + 8 * (reg >> 2) + 4 * hh;
          v2[z] = (ii >= j) ? s[reg] * fexp2((float)(ii - j) * lg) : 0.f;
        }
        pw[e] = pk_bf16(v2[0], v2[1]);
      }
#pragma unroll
      for (int s2 = 0; s2 < 2; ++s2) {
        union { uint4 u; bf16x8 v; } pb;
        pb.u = make_uint4(pw[4 * s2], pw[4 * s2 + 1], pw[4 * s2 + 2], pw[4 * s2 + 3]);
#pragma unroll
        for (int mt = 0; mt < 4; ++mt) {
          const bf16_t* vp = p.RVT + ((long)(b * 8 + hd) * 128 + mt * 32 + r) * T_ + n * 128 + jt * 32 + 16 * s2 + 4 * hh;
          const uint2 lo = *(const uint2*)vp, hi = *(const uint2*)(vp + 8);
          union { uint4 u; bf16x8 v; } av; av.u = make_uint4(lo.x, lo.y, hi.x, hi.y);
          O[mt] = __builtin_amdgcn_mfma_f32_32x32x16_bf16(av.v, pb.v, O[mt], 0, 0, 0);
        }
      }
    }
    float sum = 0.f;
#pragma unroll
    for (int mt = 0; mt < 4; ++mt)
#pragma unroll
      for (int i = 0; i < 16; ++i) sum += O[mt][i];
    sum += __shfl_xor(sum, 32);
    const float mu = sum * (1.0f / 128.0f);
    float vs = 0.f;
#pragma unroll
    for (int mt = 0; mt < 4; ++mt)
#pragma unroll
      for (int i = 0; i < 16; ++i) { const float d = O[mt][i] - mu; vs += d * d; }
    vs += __shfl_xor(vs, 32);
    const float rstd = rsqrtf(vs * (1.0f / 128.0f) + 1e-5f);
#pragma unroll
    for (int mt = 0; mt < 4; ++mt)
#pragma unroll
      for (int q = 0; q < 4; ++q) {
        const int dv = mt * 32 + 8 * q + 4 * hh;
        const uint2 g2 = *(const uint2*)(p.PROJ + tok * LDP + 6400 + hd * 128 + dv);
        const f32x4 gw4 = *(const f32x4*)(gw_ + hd * 128 + dv);
        const float g[4] = {bflo(g2.x), bfhi(g2.x), bflo(g2.y), bfhi(g2.y)};
        float o[4];
#pragma unroll
        for (int e = 0; e < 4; ++e) {
          const float nv = (O[mt][4 * q + e] - mu) * rstd * gw4[e];
          o[e] = g[e] / (1.f + __expf(-g[e])) * nv;
        }
        uint2 wv; wv.x = pk_bf16(o[0], o[1]); wv.y = pk_bf16(o[2], o[3]);
        *(uint2*)(p.BR + tok * LDB + 3072 + hd * 128 + dv) = wv;
      }
  }
}


DEV void fox_cum_phase(const Params& p, const float* fbias) {
  const int lane = tid_() & 63;
  const int gw = (bid_() * blockDim.x + tid_()) >> 6, nw = (gridDim.x * blockDim.x) >> 6;
  for (int u = gw; u < 16; u += nw) {
    const int b = u >> 3, h = u & 7;
    const float fb = fbias[h];
    const float* src = p.SMALL + ((long)b * T_ + lane * 130) * 128 + 80 + h;
    float loc = 0.f;
    for (int i = 0; i < 130; ++i) {
      const int t = lane * 130 + i;
      const float z = src[(long)i * 128] + fb;
      const float lf = fminf(z, 0.f) - __logf(1.f + __expf(-fabsf(z)));
      loc += (t >= PAD_) ? lf : 0.f;
    }
    float inc = loc;
#pragma unroll
    for (int o = 1; o < 64; o <<= 1) { const float n = __shfl_up(inc, o); if (lane >= o) inc += n; }
    float run = inc - loc;
    float* dst = p.CUM + ((long)b * T_ + lane * 130) * 8 + h;
    for (int i = 0; i < 130; ++i) {
      const int t = lane * 130 + i;
      const float z = src[(long)i * 128] + fb;
      const float lf = fminf(z, 0.f) - __logf(1.f + __expf(-fabsf(z)));
      run += (t >= PAD_) ? lf : 0.f;
      dst[(long)i * 8] = run * 1.4426950408889634f;
    }
  }
}


DEV void fox_norm_phase(const Params& p) {
  const int lane = tid_() & 63;
  const int gw = (bid_() * blockDim.x + tid_()) >> 6, nw = (gridDim.x * blockDim.x) >> 6;
  for (int u = gw; u < 16 * NCH; u += nw) {
    const int bh = u / NCH, c = u % NCH, b = bh >> 3, h = bh & 7;
    float qm = 0.f, km = 0.f;
#pragma unroll
    for (int s = 0; s < 2; ++s) {
      const long row = (long)b * T_ + c * 128 + s * 64 + lane;
      float qs = 0.f, ks = 0.f;
#pragma unroll
      for (int i = 0; i < 16; ++i) {
        const uint4 qv = *(const uint4*)(p.PROJ + row * LDP + 3328 + h * 128 + i * 8);
        const uint4 kv = *(const uint4*)(p.PROJ + row * LDP + 4352 + h * 128 + i * 8);
        const unsigned qw[4] = {qv.x, qv.y, qv.z, qv.w}, kw[4] = {kv.x, kv.y, kv.z, kv.w};
#pragma unroll
        for (int e = 0; e < 4; ++e) {
          qs += bflo(qw[e]) * bflo(qw[e]) + bfhi(qw[e]) * bfhi(qw[e]);
          ks += bflo(kw[e]) * bflo(kw[e]) + bfhi(kw[e]) * bfhi(kw[e]);
        }
      }
      qm = fmaxf(qm, qs);
      km = fmaxf(km, ks);
    }
#pragma unroll
    for (int o = 32; o > 0; o >>= 1) { qm = fmaxf(qm, __shfl_xor(qm, o)); km = fmaxf(km, __shfl_xor(km, o)); }
    if (lane == 0) { p.QN[u] = sqrtf(qm) * 1.0001f; p.KN[u] = sqrtf(km) * 1.0001f; }
  }
}

DEV int pop_unit(unsigned* ctr, char* lds) {
  volatile int* slot = (volatile int*)(lds + LDS_BYTES - 16);
  __syncthreads();
  if (tid_() == 0) *slot = (int)atomicAdd(ctr, 1u);
  __syncthreads();
  return *slot;
}

constexpr int FK_S = 272, FV_S = 136;
constexpr int FOX_BUF = 64 * FK_S + 128 * FV_S + 256;
DEV void fox_unit(const Params& p, int b, int h, int qt, char* lds) {
  const int tid = tid_(), lane = tid & 63, w = tid >> 6, r = lane & 31, hh = lane >> 5;
  const int q0 = qt * 128;
  const int qpos = q0 + w * 32 + r;
  const long qrow = (long)b * T_ + qpos;
  bf16x8 qf[8];
#pragma unroll
  for (int kk = 0; kk < 8; ++kk) qf[kk] = *(const bf16x8*)(p.PROJ + qrow * LDP + 3328 + h * 128 + kk * 16 + 8 * hh);
  const float cq = p.CUM[qrow * 8 + h];
  f32x16 O[4];
#pragma unroll
  for (int mt = 0; mt < 4; ++mt)
#pragma unroll
    for (int i = 0; i < 16; ++i) O[mt][i] = 0.f;
  float m = -1e30f, lsum = 0.f;
  const int nt = 2 * qt + 1;
  int t_start;
  {
    const int bh = b * 8 + h;
    float kall = 0.f;
    for (int c = lane; c <= qt; c += 64) kall = fmaxf(kall, p.KN[bh * NCH + c]);
#pragma unroll
    for (int o = 32; o > 0; o >>= 1) kall = fmaxf(kall, __shfl_xor(kall, o));
    const float bound = 2.f * p.QN[bh * NCH + qt] * kall + 150.f;
    const int qfirst = q0 < PAD_ ? PAD_ : q0;
    const float lim = p.CUM[((long)b * T_ + qfirst) * 8 + h] + bound;
    int first = nt;
    for (int t0 = 0; t0 < nt; t0 += 64) {
      const int t = t0 + lane;
      const bool keep = (t < nt) && (p.CUM[((long)b * T_ + 64 + t * 64 + 63) * 8 + h] <= lim);
      const unsigned long long mk = __ballot(keep);
      if (mk) { first = t0 + __ffsll((long long)mk) - 1; break; }
    }
    const int tcap = 2 * qt - 1 > 0 ? 2 * qt - 1 : 0;
    t_start = first < tcap ? first : tcap;
  }
  const bf16_t* kbase = p.PROJ + ((long)b * T_) * LDP + 4352 + h * 128;
  const bf16_t* vbase = p.FVT + ((long)(b * 8 + h) * 128) * T_;
  const float* cbase = p.CUM + ((long)b * T_) * 8 + h;
  uint4 kr0, kr1, kr2, kr3, vr0, vr1, vr2, vr3;
  float cr = 0.f;
#define FOX_GL1(i, k0_)                                                                        \
  {                                                                                            \
    const int c = tid + 256 * (i);                                                             \
    kr##i = *(const uint4*)(kbase + (long)((k0_) + (c >> 4)) * LDP + (c & 15) * 8);            \
    vr##i = *(const uint4*)(vbase + (long)(c >> 3) * T_ + (k0_) + (c & 7) * 8);                \
  }
#define FOX_GLOAD(k0_)                                                                         \
  {                                                                                            \
    FOX_GL1(0, k0_) FOX_GL1(1, k0_) FOX_GL1(2, k0_) FOX_GL1(3, k0_)                            \
    if (tid < 64) cr = cbase[(long)((k0_) + tid) * 8];                                         \
  }
#define FOX_LS1(i, buf)                                                                        \
  {                                                                                            \
    const int c = tid + 256 * (i);                                                             \
    *(uint4*)(buf + (c >> 4) * FK_S + (c & 15) * 16) = kr##i;                                  \
    char* vd = buf + 64 * FK_S + (c >> 3) * FV_S + (c & 7) * 16;                               \
    *(uint2*)vd = make_uint2(vr##i.x, vr##i.y);                                                \
    *(uint2*)(vd + 8) = make_uint2(vr##i.z, vr##i.w);                                          \
  }
#define FOX_LSTORE(buf_)                                                                       \
  {                                                                                            \
    char* buf = (buf_);                                                                        \
    FOX_LS1(0, buf) FOX_LS1(1, buf) FOX_LS1(2, buf) FOX_LS1(3, buf)                            \
    if (tid < 64) *(float*)(buf + 64 * FK_S + 128 * FV_S + tid * 4) = cr;                      \
  }
  FOX_GLOAD(64 + t_start * 64);
  FOX_LSTORE(lds + (t_start & 1) * FOX_BUF);
  __syncthreads();
  const int qwmax = q0 + w * 32 + 31;
  for (int t = t_start; t < nt; ++t) {
    const int k0 = 64 + t * 64;
    char* cur = lds + (t & 1) * FOX_BUF;
    const bool more = (t + 1) < nt;
    if (more) FOX_GLOAD(k0 + 64);
    if (k0 <= qwmax) {
      f32x16 s[2];
#pragma unroll
      for (int k2 = 0; k2 < 2; ++k2) {
#pragma unroll
        for (int i = 0; i < 16; ++i) s[k2][i] = 0.f;
#pragma unroll
        for (int kk = 0; kk < 8; ++kk) {
          const bf16x8 a = *(const bf16x8*)(cur + (k2 * 32 + r) * FK_S + kk * 32 + hh * 16);
          s[k2] = __builtin_amdgcn_mfma_f32_32x32x16_bf16(a, qf[kk], s[k2], 0, 0, 0);
        }
      }
      const float* ck = (const float*)(cur + 64 * FK_S + 128 * FV_S);
      float mx = -1e30f;
#pragma unroll
      for (int k2 = 0; k2 < 2; ++k2)
#pragma unroll
        for (int q = 0; q < 4; ++q) {
          const int key = k2 * 32 + 8 * q + 4 * hh;
          const f32x4 c4 = *(const f32x4*)(ck + key);
#pragma unroll
          for (int e = 0; e < 4; ++e) {
            const int kp = k0 + key + e;
            float z = s[k2][4 * q + e] + cq - c4[e];
            z = (kp >= PAD_ && kp <= qpos) ? z : -1e30f;
            s[k2][4 * q + e] = z;
            mx = fmaxf(mx, z);
          }
        }
      mx = fmaxf(mx, __shfl_xor(mx, 32));
      const float mn = fmaxf(m, mx);
      const float alpha = fexp2(m - mn);
      m = mn;
      lsum *= alpha;
#pragma unroll
      for (int mt = 0; mt < 4; ++mt)
#pragma unroll
        for (int i = 0; i < 16; ++i) O[mt][i] *= alpha;
#pragma unroll
      for (int k2 = 0; k2 < 2; ++k2) {
        unsigned pw[8];
#pragma unroll
        for (int e = 0; e < 8; ++e) {
          const float p0 = fexp2(s[k2][2 * e] - mn), p1 = fexp2(s[k2][2 * e + 1] - mn);
          lsum += p0 + p1;
          pw[e] = pk_bf16(p0, p1);
        }
#pragma unroll
        for (int s2 = 0; s2 < 2; ++s2) {
          union { uint4 u; bf16x8 v; } pb;
          pb.u = make_uint4(pw[4 * s2], pw[4 * s2 + 1], pw[4 * s2 + 2], pw[4 * s2 + 3]);
#pragma unroll
          for (int mt = 0; mt < 4; ++mt) {
            const char* vp = cur + 64 * FK_S + (mt * 32 + r) * FV_S + (k2 * 32 + 16 * s2 + 4 * hh) * 2;
            const uint2 lo = *(const uint2*)vp, hi = *(const uint2*)(vp + 16);
            union { uint4 u; bf16x8 v; } av;
            av.u = make_uint4(lo.x, lo.y, hi.x, hi.y);
            O[mt] = __builtin_amdgcn_mfma_f32_32x32x16_bf16(av.v, pb.v, O[mt], 0, 0, 0);
          }
        }
      }
    }
    if (more) FOX_LSTORE(lds + ((t + 1) & 1) * FOX_BUF);
    __syncthreads();
  }
  lsum += __shfl_xor(lsum, 32);
  const float inv = (qpos >= PAD_) ? 1.f / lsum : 0.f;
#pragma unroll
  for (int mt = 0; mt < 4; ++mt)
#pragma unroll
    for (int q = 0; q < 4; ++q) {
      const int dv = mt * 32 + 8 * q + 4 * hh;
      uint2 wv;
      wv.x = pk_bf16(O[mt][4 * q] * inv, O[mt][4 * q + 1] * inv);
      wv.y = pk_bf16(O[mt][4 * q + 2] * inv, O[mt][4 * q + 3] * inv);
      *(uint2*)(p.BR + qrow * LDB + 2048 + h * 128 + dv) = wv;
    }
}


DEV void cnorm_phase(const Params& p, const float* g) {
  const int lane = tid_() & 63;
  const int gw = (bid_() * blockDim.x + tid_()) >> 6, nw = (gridDim.x * blockDim.x) >> 6;
  for (int row = gw; row < M_; row += nw) {
    const uint2 raw = *(const uint2*)(p.PROJ + (long)row * LDP + 2048 + lane * 4);
    const float v[4] = {bflo(raw.x), bfhi(raw.x), bflo(raw.y), bfhi(raw.y)};
    float ss = v[0] * v[0] + v[1] * v[1] + v[2] * v[2] + v[3] * v[3];
#pragma unroll
    for (int o = 32; o > 0; o >>= 1) ss += __shfl_xor(ss, o);
    const float rs = rsqrtf(ss * (1.0f / 256.0f) + 1e-6f);
    const f32x4 gg = *(const f32x4*)(g + lane * 4);
    uint2 o;
    o.x = pk_bf16(v[0] * rs * gg[0], v[1] * rs * gg[1]);
    o.y = pk_bf16(v[2] * rs * gg[2], v[3] * rs * gg[3]);
    *(uint2*)(p.CN + (long)row * 256 + lane * 4) = o;
  }
}

DEV unsigned prune256(unsigned* buf, int cnt, int lane, unsigned* hist) {
  unsigned k[16];
#pragma unroll
  for (int i = 0; i < 16; ++i) k[i] = (i * 64 + lane < cnt) ? buf[i * 64 + lane] : 0u;
  unsigned prefix = 0;
  unsigned need = 256;
#pragma unroll 1
  for (int pass = 0; pass < 4; ++pass) {
    const int sh = 24 - 8 * pass;
    const unsigned himask = pass == 0 ? 0u : (0xFFFFFFFFu << (sh + 8));
    *(uint4*)(hist + lane * 4) = make_uint4(0u, 0u, 0u, 0u);
    asm volatile("s_waitcnt lgkmcnt(0)" ::: "memory");
#pragma unroll
    for (int i = 0; i < 16; ++i)
      if ((i * 64 + lane < cnt) && ((k[i] & himask) == prefix)) atomicAdd(hist + ((k[i] >> sh) & 255u), 1u);
    asm volatile("s_waitcnt lgkmcnt(0)" ::: "memory");
    const uint4 h4 = *(const uint4*)(hist + lane * 4);
    asm volatile("s_waitcnt lgkmcnt(0)" ::: "memory");
    const unsigned s3 = h4.w, s2 = s3 + h4.z, s1 = s2 + h4.y, s0 = s1 + h4.x;
    unsigned v = s0;
#pragma unroll
    for (int o = 1; o < 64; o <<= 1) { const unsigned t = __shfl_down(v, o); if (lane + o < 64) v += t; }
    const unsigned above = v - s0;
    const unsigned long long mk = __ballot(above + s0 >= need);
    const int ls = 63 - __clzll((long long)mk);
    int j = 0; unsigned gt = s1;
    if (above + s1 >= need) { j = 1; gt = s2; }
    if (above + s2 >= need) { j = 2; gt = s3; }
    if (above + s3 >= need) { j = 3; gt = 0u; }
    const unsigned dsel = (unsigned)__shfl((int)(lane * 4 + j), ls);
    const unsigned ngt = (unsigned)__shfl((int)(above + gt), ls);
    prefix |= dsel << sh;
    need -= ngt;
  }
  const unsigned T = prefix;
  int base = 0;
  const unsigned long long lt = (1ull << lane) - 1ull;
#pragma unroll
  for (int i = 0; i < 16; ++i) {
    const bool pass = (i * 64 + lane < cnt) && (k[i] >= T);
    const unsigned long long mk = __ballot(pass);
    if (pass) buf[base + __popcll(mk & lt)] = k[i];
    base += __popcll(mk);
  }
  return T;
}

DEV void index_unit(const Params& p, int b, int t0, char* lds) {
  const int tid = tid_(), lane = tid & 63, w = tid >> 6, r = lane & 31, hh = lane >> 5;
  unsigned* bufA = (unsigned*)lds + (w * 2) * 1024;
  unsigned* bufB = bufA + 1024;
  unsigned* mybuf = hh ? bufB : bufA;
  unsigned* hist = (unsigned*)(lds + 32768) + w * 256;
  const int tq = t0 + 2 * w + hh;
  const long rowq = (long)b * T_ + tq;
  if (t0 + 7 < PAD_) { if (r == 0) p.NIDX[rowq] = 0; return; }
  bf16x8 qa[4];
  {
    const int qsel = (r >> 2) & 1, head = (r & 3) + 4 * (r >> 3);
    const bf16_t* qp = p.PROJ + ((long)b * T_ + t0 + 2 * w + qsel) * LDP + 2304 + head * 64 + hh * 32;
#pragma unroll
    for (int kk = 0; kk < 4; ++kk) qa[kk] = *(const bf16x8*)(qp + kk * 8);
  }
  float wq[16];
#pragma unroll
  for (int q = 0; q < 4; ++q) {
    const f32x4 w4 = *(const f32x4*)(p.SMALL + rowq * 128 + 64 + 4 * q);
#pragma unroll
    for (int e = 0; e < 4; ++e) wq[4 * q + e] = w4[e] * 0.25f;
  }
  int cntA = 0, cntB = 0;
  unsigned thrA = 0, thrB = 0;
  const int tmax = t0 + 2 * w + 1;
  const bf16_t* kbase = p.IK16 + ((long)b * T_) * 64 + hh * 32;
#define IDX_KLOAD(dst, kb_)                                                               \
  {                                                                                       \
    const int _k = (kb_) + r;                                                             \
    const bf16_t* _kp = kbase + (long)(_k < T_ ? _k : T_ - 1) * 64;                        \
    dst##0 = *(const bf16x8*)(_kp);                                                       \
    dst##1 = *(const bf16x8*)(_kp + 8);                                                   \
    dst##2 = *(const bf16x8*)(_kp + 16);                                                  \
    dst##3 = *(const bf16x8*)(_kp + 24);                                                  \
  }
  bf16x8 kc0, kc1, kc2, kc3, kd0, kd1, kd2, kd3, ke0, ke1, ke2, ke3;
  IDX_KLOAD(kc, PAD_);
  IDX_KLOAD(kd, PAD_ + 32);
  for (int kb = PAD_; kb <= tmax; kb += 32) {
    IDX_KLOAD(ke, kb + 64);
    if (cntA > 992) { thrA = prune256(bufA, cntA, lane, hist); cntA = 256; }
    if (cntB > 992) { thrB = prune256(bufB, cntB, lane, hist); cntB = 256; }
    const int key = kb + r;
    f32x16 acc;
#pragma unroll
    for (int i = 0; i < 16; ++i) acc[i] = 0.f;
    acc = __builtin_amdgcn_mfma_f32_32x32x16_bf16(qa[0], kc0, acc, 0, 0, 0);
    acc = __builtin_amdgcn_mfma_f32_32x32x16_bf16(qa[1], kc1, acc, 0, 0, 0);
    acc = __builtin_amdgcn_mfma_f32_32x32x16_bf16(qa[2], kc2, acc, 0, 0, 0);
    acc = __builtin_amdgcn_mfma_f32_32x32x16_bf16(qa[3], kc3, acc, 0, 0, 0);
    kc0 = kd0; kc1 = kd1; kc2 = kd2; kc3 = kd3;
    kd0 = ke0; kd1 = ke1; kd2 = ke2; kd3 = ke3;
    float sc = 0.f;
#pragma unroll
    for (int i = 0; i < 16; ++i) { const int xb = __float_as_int(acc[i]); sc += wq[i] * __int_as_float(xb > 0 ? xb : 0); }
    const unsigned ub = __float_as_uint(sc);
    const unsigned ord = ub ^ ((ub >> 31) ? 0xFFFFFFFFu : 0x80000000u);
    const unsigned packed = (ord & 0xFFFFC000u) | (unsigned)(16383 - key);
    const bool pass = (key <= tq) && (packed > (hh ? thrB : thrA));
    const unsigned long long mk = __ballot(pass);
    const unsigned mA = (unsigned)mk, mB = (unsigned)(mk >> 32);
    const unsigned mine = hh ? mB : mA;
    if (pass) mybuf[(hh ? cntB : cntA) + __popc(mine & ((1u << r) - 1u))] = packed;
    cntA += __popc(mA);
    cntB += __popc(mB);
  }
#undef IDX_KLOAD
  if (cntA > 256) { prune256(bufA, cntA, lane, hist); cntA = 256; }
  if (cntB > 256) { prune256(bufB, cntB, lane, hist); cntB = 256; }
#pragma unroll
  for (int s = 0; s < 2; ++s) {
    const unsigned* bf = s ? bufB : bufA;
    const int cnt = s ? cntB : cntA;
    const long row = (long)b * T_ + t0 + 2 * w + s;
#pragma unroll
    for (int i = 0; i < 4; ++i) {
      const int j = i * 64 + lane;
      p.IDX[row * 256 + j] = (j < cnt) ? (16383 - (int)(bf[j] & 0x3FFFu)) : PAD_;
    }
    if (lane == 0) p.NIDX[row] = (t0 + 2 * w + s >= PAD_) ? cnt : 0;
  }
}

DEV void index_phase(const Params& p, int l, char* lds, int rep = 0) {
  for (;;) {
    const int u = pop_unit(p.CNT + 24 + l + rep * 16, lds);
    if (u >= 2080) break;
    const int b = u & 1, t0 = (1039 - (u >> 1)) * 8;
    index_unit(p, b, t0, lds);
  }
}

typedef short s16x4 __attribute__((ext_vector_type(4)));
DEV int t5_bucket(int dist) {
  const float d = (float)(dist < 1 ? 1 : dist);
  int large = 16 + (int)(__logf(d * 0.0625f) * (16.0f / 2.0794415416798357f));
  large = large < 31 ? large : 31;
  return dist < 16 ? dist : large;
}

constexpr int DRS = 528;
DEV void dsa_unit(const Params& p, int b, int t0, char* lds) {
  const int tid = tid_(), lane = tid & 63, w = tid >> 6, c16 = lane & 15, g = lane >> 4;
  const int tq = t0 + w;
  const long row = (long)b * T_ + tq;
  char* wl = lds + w * (32 * DRS);
  if (tq < PAD_) {
#pragma unroll
    for (int i = 0; i < 4; ++i) *(uint4*)(p.BR + row * LDB + (i * 64 + lane) * 8) = make_uint4(0, 0, 0, 0);
    return;
  }
  const int n = p.NIDX[row];
  const bf16_t* qptr0 = p.PROJ + row * LDP + (c16 & 7) * 256 + 8 * g;
  f32x4 O[16];
#pragma unroll
  for (int mt = 0; mt < 16; ++mt) O[mt] = (f32x4){0.f, 0.f, 0.f, 0.f};
  float m = -1e30f, lsum = 0.f;
  const int nch = (n + 31) >> 5;
  const int head = c16 & 7;
  for (int ch = 0; ch < nch; ++ch) {
    const int slot = ch * 32 + (lane & 31);
    const int myidx = (slot < n) ? p.IDX[row * 256 + slot] : PAD_;
#pragma unroll
    for (int i = 0; i < 16; ++i) {
      const int kr = 2 * i + (lane >> 5);
      const int kidx = __shfl(myidx, kr);
      const uint4 v = *(const uint4*)(p.CN + ((long)b * T_ + kidx) * 256 + (lane & 31) * 8);
      *(uint4*)(wl + kr * DRS + (lane & 31) * 16) = v;
    }
    __builtin_amdgcn_fence(__ATOMIC_RELEASE, "wavefront");
    asm volatile("s_waitcnt lgkmcnt(0)" ::: "memory");
    f32x4 s[2];
    s[0] = (f32x4){0.f, 0.f, 0.f, 0.f};
    s[1] = (f32x4){0.f, 0.f, 0.f, 0.f};
    {
      const bf16_t* qptr = qptr0;
      asm volatile("" : "+v"(qptr));
#pragma unroll
      for (int ks = 0; ks < 8; ++ks) {
        const bf16x8 qv = *(const bf16x8*)(qptr + ks * 32);
        const bf16x8 a0 = *(const bf16x8*)(wl + c16 * DRS + ks * 64 + g * 16);
        const bf16x8 a1 = *(const bf16x8*)(wl + (16 + c16) * DRS + ks * 64 + g * 16);
        s[0] = __builtin_amdgcn_mfma_f32_16x16x32_bf16(a0, qv, s[0], 0, 0, 0);
        s[1] = __builtin_amdgcn_mfma_f32_16x16x32_bf16(a1, qv, s[1], 0, 0, 0);
      }
    }
    float mx = -1e30f;
#pragma unroll
    for (int tl = 0; tl < 2; ++tl)
#pragma unroll
      for (int e = 0; e < 4; ++e) {
        const int kslot = tl * 16 + 4 * g + e;
        const int kidx = __shfl(myidx, kslot);
        const float bias = p.t5[t5_bucket(tq - kidx) * 8 + head] * 1.4426950408889634f;
        float z = s[tl][e] + bias;
        z = (ch * 32 + kslot < n) ? z : -1e30f;
        s[tl][e] = z;
        mx = fmaxf(mx, z);
      }
    mx = fmaxf(mx, __shfl_xor(mx, 16));
    mx = fmaxf(mx, __shfl_xor(mx, 32));
    const float mn = fmaxf(m, mx);
    const float alpha = fexp2(m - mn);
    m = mn;
    lsum *= alpha;
#pragma unroll
    for (int mt = 0; mt < 16; ++mt) O[mt] *= alpha;
    float pv[8];
#pragma unroll
    for (int tl = 0; tl < 2; ++tl)
#pragma unroll
      for (int e = 0; e < 4; ++e) { pv[tl * 4 + e] = fexp2(s[tl][e] - mn); lsum += pv[tl * 4 + e]; }
    union { uint4 u; bf16x8 v; } pb;
    pb.u = make_uint4(pk_bf16(pv[0], pv[1]), pk_bf16(pv[2], pv[3]), pk_bf16(pv[4], pv[5]), pk_bf16(pv[6], pv[7]));
    const int qq = c16 >> 2, pp = c16 & 3;
#pragma unroll
    for (int mt = 0; mt < 16; ++mt) {
      const char* a0 = wl + (4 * g + qq) * DRS + (mt * 16 + 4 * pp) * 2;
      const s16x4 lo = __builtin_amdgcn_ds_read_tr16_b64_v4i16((__attribute__((address_space(3))) s16x4*)a0);
      const s16x4 hi = __builtin_amdgcn_ds_read_tr16_b64_v4i16((__attribute__((address_space(3))) s16x4*)(a0 + 16 * DRS));
      bf16x8 av;
      av[0] = lo[0]; av[1] = lo[1]; av[2] = lo[2]; av[3] = lo[3];
      av[4] = hi[0]; av[5] = hi[1]; av[6] = hi[2]; av[7] = hi[3];
      O[mt] = __builtin_amdgcn_mfma_f32_16x16x32_bf16(av, pb.v, O[mt], 0, 0, 0);
    }
    asm volatile("s_waitcnt lgkmcnt(0)" ::: "memory");
  }
  lsum += __shfl_xor(lsum, 16);
  lsum += __shfl_xor(lsum, 32);
  const float inv = 1.f / lsum;
  if (c16 < 8) {
#pragma unroll
    for (int mt = 0; mt < 16; ++mt) {
      uint2 wv;
      wv.x = pk_bf16(O[mt][0] * inv, O[mt][1] * inv);
      wv.y = pk_bf16(O[mt][2] * inv, O[mt][3] * inv);
      *(uint2*)(p.BR + row * LDB + c16 * 256 + mt * 16 + 4 * g) = wv;
    }
  }
}

DEV void attn_phase(const Params& p, int l, char* lds, int rep = 0) {
  for (;;) {
    const int u = pop_unit(p.CNT + 16 + l + rep * 16, lds);
    if (u >= 1040 + 4160) break;
    if (u < 1040) {
      const int qt = 64 - (u >> 4), b = (u >> 3) & 1, h = u & 7;
      fox_unit(p, b, h, qt, lds);
    } else {
      const int v = u - 1040, b = v & 1, t0 = (v >> 1) * 4;
      dsa_unit(p, b, t0, lds);
    }
  }
}

constexpr int BRANCH_MASK = 7;
DEV void merge_phase(const Params& p, char* lds) {
  const int lane = tid_() & 63, wid = tid_() >> 6, wr = wid >> 1, wc = wid & 1, r = lane & 31, hh = lane >> 5;
  uint4* stb = (uint4*)p.STASH + (long)bid_() * (24 * 256) + tid_();
  f32x4* sto = (f32x4*)((uint4*)p.STASH + (long)bid_() * (24 * 256) + 8 * 256) + tid_();
  int jfirst = 0, jlast = 2;
  while (!((BRANCH_MASK >> jfirst) & 1)) ++jfirst;
  while (!((BRANCH_MASK >> jlast) & 1)) --jlast;
  TILE_LOOP(130, 16) {
#pragma unroll 1
    for (int j = jfirst; j <= jlast; ++j) {
      if (!((BRANCH_MASK >> j) & 1)) continue;
      {
        f32x16 ab[2][2];
        zero_acc(ab);
        const bf16_t* wb = j == 0 ? p.Wb0 : (j == 1 ? p.Wb1 : p.Wb2);
        const int kj = j == 0 ? 2048 : 1024;
        const int co = j == 0 ? 0 : (j == 1 ? 2048 : 3072);
        gemm_kloop(wb + (long)pn * 128 * kj, kj, p.BR + (long)pm * 128 * LDB + co, LDB, kj, ab, lds);
#pragma unroll
        for (int a = 0; a < 2; ++a)
#pragma unroll
          for (int c = 0; c < 2; ++c) {
            unsigned w[8];
#pragma unroll
            for (int e = 0; e < 8; ++e) w[e] = pk_bf16(ab[a][c][2 * e], ab[a][c][2 * e + 1]);
            stb[((a * 2 + c) * 2) * 256] = make_uint4(w[0], w[1], w[2], w[3]);
            stb[((a * 2 + c) * 2 + 1) * 256] = make_uint4(w[4], w[5], w[6], w[7]);
          }
      }
      f32x16 ag[2][2];
      zero_acc(ag);
      gemm_kloop(p.Wgt + ((long)j * 2048 + pn * 128) * D_, D_, p.H + (long)pm * 128 * D_, D_, D_, ag, lds);
#pragma unroll
      for (int mi = 0; mi < 2; ++mi)
#pragma unroll
        for (int ni = 0; ni < 2; ++ni) {
          const long tok = (long)pm * 128 + wc * 64 + ni * 32 + r;
          const uint4 s0 = stb[((mi * 2 + ni) * 2) * 256], s1 = stb[((mi * 2 + ni) * 2 + 1) * 256];
          const unsigned w[8] = {s0.x, s0.y, s0.z, s0.w, s1.x, s1.y, s1.z, s1.w};
#pragma unroll
          for (int q = 0; q < 4; ++q) {
            f32x4 v;
#pragma unroll
            for (int e = 0; e < 4; ++e) {
              const float g = 1.f / (1.f + __expf(-ag[mi][ni][4 * q + e]));
              const unsigned ww = w[2 * q + (e >> 1)];
              v[e] = g * ((e & 1) ? bfhi(ww) : bflo(ww));
            }
            if (j != jfirst) { const f32x4 o = sto[((mi * 2 + ni) * 4 + q) * 256]; v += o; }
            if (j != jlast) sto[((mi * 2 + ni) * 4 + q) * 256] = v;
            else {
              uint2 wv; wv.x = pk_bf16(v[0], v[1]); wv.y = pk_bf16(v[2], v[3]);
              *(uint2*)(lds + wid * (64 * 144) + (ni * 32 + r) * 144 + (mi * 32 + 8 * q + 4 * hh) * 2) = wv;
            }
          }
        }
    }
    asm volatile("s_waitcnt lgkmcnt(0)" ::: "memory");
    {
      const char* stg = lds + wid * (64 * 144);
      const int trow = lane >> 3, ch = lane & 7;
      bf16_t* dst = p.MERGED + ((long)pm * 128 + wc * 64 + trow) * D_ + pn * 128 + wr * 64 + ch * 8;
#pragma unroll
      for (int i = 0; i < 8; ++i) *(uint4*)(dst + (long)(8 * i) * D_) = *(const uint4*)(stg + (trow + 8 * i) * 144 + ch * 16);
    }
    __syncthreads();
  }
}

DEV void layer_body(const Params& p, const int l, char* lds, cg::grid_group& grid) {
    conv_ffn(p, p.ffn1_w1 + (long)l * D_ * DFF, p.ffn1_w3 + (long)l * D_ * DFF, p.ffn1_w2 + (long)l * DFF * D_, lds);
    conv_mixer(p, l, lds);
    if (l == 0) rope_table_phase(p);
    norm_phase(p, p.ffn1_norm + l * D_, p.H, l == 0 ? 1 : 0);
    grid.sync();
    ffn_up_phase(p, lds);
    grid.sync();
    resid_gemm_phase(p, p.W2t, p.HID, DFF, 0.5f, lds);
    grid.sync();
    norm_phase(p, p.mix_norm + l * D_, p.H, 0);
    grid.sync();
    proj_phase(p, lds);
    grid.sync();
    ret_kv_phase(p);
    fox_cum_phase(p, p.f_bias + l * 8);
    fox_norm_phase(p);
    cnorm_phase(p, p.kv_norm + l * 256);
    index_phase(p, l, lds);
    grid.sync();
    ret_scan_phase(p);
    attn_phase(p, l, lds);
    grid.sync();
    ret_out_phase(p, p.gn_w + l * 1024);
    grid.sync();
    merge_phase(p, lds);
    grid.sync();
    conv_ffn(p, p.ffn2_w1 + (long)l * D_ * DFF, p.ffn2_w3 + (long)l * D_ * DFF, p.ffn2_w2 + (long)l * DFF * D_, lds);
    resid_gemm_phase(p, p.Wot, p.MERGED, D_, 1.0f, lds);
    grid.sync();
    norm_phase(p, p.ffn2_norm + l * D_, p.H, 0);
    grid.sync();
    ffn_up_phase(p, lds);
    grid.sync();
    resid_gemm_phase(p, p.W2t, p.HID, DFF, 0.5f, lds);
    grid.sync();
}

__global__ void __launch_bounds__(256, 2) mega(Params p) {
  cg::grid_group grid = cg::this_grid();
  __shared__ __attribute__((aligned(16))) char lds[LDS_BYTES];
  if (bid_() == 0 && tid_() < 64) p.CNT[tid_()] = 0;
  layer_body(p, 0, lds, grid);
  layer_body(p, 1, lds, grid);
  final_norm_phase(p);
}

extern "C" void kernel_launch(void* const* d_in, const int* in_sizes, int n_in, void* d_out, int out_size, void* d_ws,
                              size_t ws_size, hipStream_t stream) {
  static int grid_blocks = 0;
  if (!grid_blocks) {
    int dev = 0, cus = 0, per_cu = 0;
    hipGetDevice(&dev);
    hipDeviceGetAttribute(&cus, hipDeviceAttributeMultiprocessorCount, dev);
    hipOccupancyMaxActiveBlocksPerMultiprocessor(&per_cu, mega, 256, 0);
    if (per_cu > 2) per_cu = 2;
    grid_blocks = (cus * per_cu) & ~7;
  }
  Params p{};
  const float* const* in = (const float* const*)d_in;
  p.x = in[0]; p.meta = in[1]; p.t5 = in[2]; p.ffn1_norm = in[3]; p.ffn1_w1 = in[4]; p.ffn1_w3 = in[5]; p.ffn1_w2 = in[6];
  p.mix_norm = in[7]; p.w_in = in[8]; p.kv_norm = in[9]; p.w_uk = in[10]; p.w_uv = in[11]; p.f_bias = in[12]; p.gn_w = in[13];
  p.w_branch = in[14]; p.w_out = in[15]; p.ffn2_norm = in[16]; p.ffn2_w1 = in[17]; p.ffn2_w3 = in[18]; p.ffn2_w2 = in[19];
  p.final_norm = in[20];
  p.out = (float*)d_out;
  char* w = (char*)d_ws;
  size_t off = 0;
  auto take = [&](size_t bytes) { char* r = w + off; off += (bytes + 255) & ~(size_t)255; return r; };
  p.CNT = (unsigned*)take(4096);
  p.W13 = (bf16_t*)take((size_t)2 * DFF * D_ * 2);
  p.W2t = (bf16_t*)take((size_t)D_ * DFF * 2);
  p.Wint = (bf16_t*)take((size_t)NIN * D_ * 2);
  p.Wgt = (bf16_t*)take((size_t)6144 * D_ * 2);
  p.Wb0 = (bf16_t*)take((size_t)D_ * 2048 * 2);
  p.Wb1 = (bf16_t*)take((size_t)D_ * 1024 * 2);
  p.Wb2 = (bf16_t*)take((size_t)D_ * 1024 * 2);
  p.Wot = (bf16_t*)take((size_t)D_ * D_ * 2);
  p.X = (float*)take((size_t)M_ * D_ * 4);
  p.H = (bf16_t*)take((size_t)M_ * D_ * 2);
  p.PROJ = (bf16_t*)take((size_t)M_ * LDP * 2);
  p.HID = p.PROJ;
  p.MERGED = p.PROJ;
  p.BR = (bf16_t*)take((size_t)M_ * LDB * 2);
  p.FVT = (bf16_t*)take((size_t)M_ * 1024 * 2);
  p.RKT = (bf16_t*)take((size_t)M_ * 512 * 2);
  p.RVT = (bf16_t*)take((size_t)M_ * 1024 * 2);
  p.CN = (bf16_t*)take((size_t)M_ * 256 * 2);
  p.IK16 = (bf16_t*)take((size_t)M_ * 64 * 2);
  p.SMALL = (float*)take((size_t)M_ * 128 * 4);
  p.CUM = (float*)take((size_t)M_ * 8 * 4);
  p.QN = (float*)take((size_t)16 * NCH * 4);
  p.KN = (float*)take((size_t)16 * NCH * 4);
  p.KV = (float*)take((size_t)NCH * 2 * 8 * 64 * 128 * 4);
  p.ST = p.KV;
  p.ROPE = (float*)take((size_t)T_ * 64 * 4);
  p.IDX = (int*)take((size_t)M_ * 256 * 4);
  p.NIDX = (int*)take((size_t)M_ * 4);
  p.STASH = (bf16_t*)take((size_t)512 * 24 * 256 * 16);
  if (off > ws_size) { fprintf(stderr, "workspace too small: need %zu have %zu\n", off, ws_size); return; }
  void* args[] = {&p};
  hipError_t e = hipLaunchCooperativeKernel((void*)mega, dim3(grid_blocks), dim3(256), args, 0, stream);
  if (e != hipSuccess) fprintf(stderr, "cooperative launch failed: %s (grid %d)\n", hipGetErrorString(e), grid_blocks);
}
```

```cpp
#include <hip/hip_runtime.h>
#include <hip/hip_cooperative_groups.h>
#include <cstdio>
#include <cstdint>
namespace cg = cooperative_groups;

typedef unsigned short bf16_t;
typedef short bf16x8 __attribute__((ext_vector_type(8)));
typedef float f32x16 __attribute__((ext_vector_type(16)));
typedef float f32x4 __attribute__((ext_vector_type(4)));
#define DEV __device__ __forceinline__

constexpr int T_ = 8320, M_ = 16640, D_ = 2048, DFF = 5632, NCH = 65, PAD_ = 112, SEQ_ = 8192;
constexpr int DIN = 14680;
constexpr int LDP = 7424, LDB = 4096;
constexpr int NIN = 9728;
constexpr int GS = 144;
constexpr int TILE_B = 128 * GS;
constexpr int LDS_BYTES = 4 * TILE_B;

struct Params {
  const float *x, *meta, *t5, *ffn1_norm, *ffn1_w1, *ffn1_w3, *ffn1_w2, *mix_norm, *w_in, *kv_norm, *w_uk, *w_uv,
      *f_bias, *gn_w, *w_branch, *w_out, *ffn2_norm, *ffn2_w1, *ffn2_w3, *ffn2_w2, *final_norm;
  float* out;
  bf16_t *W13, *W2t, *Wint, *Wgt, *Wb0, *Wb1, *Wb2, *Wot;
  float* X;
  bf16_t *H, *PROJ, *HID, *MERGED, *BR, *FVT, *RKT, *RVT, *CN, *IK16;
  float *SMALL, *CUM, *KV, *ST, *ROPE, *QN, *KN;
  int* IDX;
  int* NIDX;
  bf16_t* STASH;
  unsigned* CNT;
};

DEV float fexp2(float x) { return __builtin_amdgcn_exp2f(x); }
DEV int tid_() { int t = threadIdx.x; asm volatile("" : "+v"(t)); return t; }
DEV int bid_() { int b = blockIdx.x; asm volatile("" : "+s"(b)); return b; }
typedef __bf16 bf16x2_t __attribute__((ext_vector_type(2)));
typedef float f32x2_t __attribute__((ext_vector_type(2)));
DEV unsigned pk_bf16(float lo, float hi) {
  f32x2_t f = {lo, hi};
  bf16x2_t b = __builtin_convertvector(f, bf16x2_t);
  return __builtin_bit_cast(unsigned, b);
}
DEV float bf2f(unsigned v) { return __uint_as_float(v << 16); }
DEV float bflo(unsigned v) { return __uint_as_float(v << 16); }
DEV float bfhi(unsigned v) { return __uint_as_float(v & 0xffff0000u); }

template <class ColFn>
DEV void conv_t(bf16_t* __restrict__ dst, int nrows, int K, ColFn colfn, char* ldsraw) {
  float (*tl)[68] = (float (*)[68])ldsraw;
  const int tid = tid_();
  const int tk = K / 64, ntile = (nrows / 64) * tk;
  for (int u = bid_(); u < ntile; u += gridDim.x) {
    const int n0 = (u / tk) * 64, k0 = (u % tk) * 64;
    {
      const int n4 = (tid & 15) * 4, kb = tid >> 4;
      long ld; const float* col = colfn(n0 + n4, ld);
#pragma unroll
      for (int i = 0; i < 4; ++i) {
        const int kl = kb + 16 * i;
        const f32x4 v = col ? *(const f32x4*)(col + (long)(k0 + kl) * ld) : (f32x4){0.f, 0.f, 0.f, 0.f};
        *(f32x4*)&tl[kl][n4] = v;
      }
    }
    __syncthreads();
    {
      const int row = tid >> 2, kc = (tid & 3) * 16;
      unsigned w[8];
#pragma unroll
      for (int j = 0; j < 8; ++j) w[j] = pk_bf16(tl[kc + 2 * j][row], tl[kc + 2 * j + 1][row]);
      uint4* d = (uint4*)(dst + (long)(n0 + row) * K + k0 + kc);
      d[0] = make_uint4(w[0], w[1], w[2], w[3]);
      d[1] = make_uint4(w[4], w[5], w[6], w[7]);
    }
    __syncthreads();
  }
}

constexpr int GT_B = 128 * 128;
DEV void gemm_kloop(const bf16_t* __restrict__ Wp, long ldw, const bf16_t* __restrict__ Xp, long ldx, int K,
                    f32x16 (&acc)[2][2], char* lds) {
  const int tid = tid_(), lane = tid & 63, wid = tid >> 6, wr = wid >> 1, wc = wid & 1;
  const int r = lane & 31, hh = lane >> 5;
  const int srow = tid >> 3, sc = (tid & 7) ^ ((tid >> 4) & 7);
  const bf16_t* wsrc = Wp + (long)srow * ldw + sc * 8;
  const bf16_t* xsrc = Xp + (long)srow * ldx + sc * 8;
  typedef __attribute__((address_space(3))) unsigned lds_u32;
  typedef const __attribute__((address_space(1))) unsigned glb_u32;
#define G_DMA(buf, ko)                                                                                         \
  {                                                                                                            \
    char* _d = (buf) + tid * 16;                                                                               \
    __builtin_amdgcn_global_load_lds((glb_u32*)(wsrc + (ko)), (lds_u32*)(_d), 16, 0, 0);                       \
    __builtin_amdgcn_global_load_lds((glb_u32*)(wsrc + (long)32 * ldw + (ko)), (lds_u32*)(_d + 4096), 16, 0, 0);   \
    __builtin_amdgcn_global_load_lds((glb_u32*)(wsrc + (long)64 * ldw + (ko)), (lds_u32*)(_d + 8192), 16, 0, 0);   \
    __builtin_amdgcn_global_load_lds((glb_u32*)(wsrc + (long)96 * ldw + (ko)), (lds_u32*)(_d + 12288), 16, 0, 0);  \
    __builtin_amdgcn_global_load_lds((glb_u32*)(xsrc + (ko)), (lds_u32*)(_d + GT_B), 16, 0, 0);                \
    __builtin_amdgcn_global_load_lds((glb_u32*)(xsrc + (long)32 * ldx + (ko)), (lds_u32*)(_d + GT_B + 4096), 16, 0, 0);  \
    __builtin_amdgcn_global_load_lds((glb_u32*)(xsrc + (long)64 * ldx + (ko)), (lds_u32*)(_d + GT_B + 8192), 16, 0, 0);  \
    __builtin_amdgcn_global_load_lds((glb_u32*)(xsrc + (long)96 * ldx + (ko)), (lds_u32*)(_d + GT_B + 12288), 16, 0, 0); \
  }
  const int swz = (r >> 1) & 7;
  const int aoff = (wr * 64 + r) * 128;
  const int boff = GT_B + (wc * 64 + r) * 128;
  const int c0 = ((0 + hh) ^ swz) << 4, c1 = ((2 + hh) ^ swz) << 4, c2 = ((4 + hh) ^ swz) << 4, c3 = ((6 + hh) ^ swz) << 4;
#define G_FRAGS(cur, co, A0, A1, B0, B1)                                                             \
  A0 = *(const bf16x8*)((cur) + aoff + (co));                                                        \
  A1 = *(const bf16x8*)((cur) + aoff + 32 * 128 + (co));                                             \
  B0 = *(const bf16x8*)((cur) + boff + (co));                                                        \
  B1 = *(const bf16x8*)((cur) + boff + 32 * 128 + (co));
#define G_MMA(A0, A1, B0, B1)                                                                        \
  acc[0][0] = __builtin_amdgcn_mfma_f32_32x32x16_bf16(A0, B0, acc[0][0], 0, 0, 0);                   \
  acc[0][1] = __builtin_amdgcn_mfma_f32_32x32x16_bf16(A0, B1, acc[0][1], 0, 0, 0);                   \
  acc[1][0] = __builtin_amdgcn_mfma_f32_32x32x16_bf16(A1, B0, acc[1][0], 0, 0, 0);                   \
  acc[1][1] = __builtin_amdgcn_mfma_f32_32x32x16_bf16(A1, B1, acc[1][1], 0, 0, 0);
#define G_COMPUTE(cur)                                                                               \
  {                                                                                                  \
    bf16x8 pa0, pa1, pb0, pb1, qa0, qa1, qb0, qb1;                                                   \
    G_FRAGS(cur, c0, pa0, pa1, pb0, pb1)                                                             \
    G_FRAGS(cur, c1, qa0, qa1, qb0, qb1)                                                             \
    __builtin_amdgcn_s_setprio(1);                                                                   \
    G_MMA(pa0, pa1, pb0, pb1)                                                                        \
    G_FRAGS(cur, c2, pa0, pa1, pb0, pb1)                                                             \
    G_MMA(qa0, qa1, qb0, qb1)                                                                        \
    G_FRAGS(cur, c3, qa0, qa1, qb0, qb1)                                                             \
    G_MMA(pa0, pa1, pb0, pb1)                                                                        \
    G_MMA(qa0, qa1, qb0, qb1)                                                                        \
    __builtin_amdgcn_sched_group_barrier(0x100, 8, 0);                                               \
    __builtin_amdgcn_sched_group_barrier(0x008, 4, 0);                                               \
    __builtin_amdgcn_sched_group_barrier(0x100, 4, 0);                                               \
    __builtin_amdgcn_sched_group_barrier(0x008, 4, 0);                                               \
    __builtin_amdgcn_sched_group_barrier(0x100, 4, 0);                                               \
    __builtin_amdgcn_sched_group_barrier(0x008, 8, 0);                                               \
    __builtin_amdgcn_s_setprio(0);                                                                   \
  }
  const int nk = K >> 6;
  char* buf0 = lds;
  char* buf1 = lds + 2 * GT_B;
  G_DMA(buf0, 0);
  __syncthreads();
  for (int kt = 0; kt < nk; kt += 2) {
    G_DMA(buf1, (kt + 1) * 64);
    G_COMPUTE(buf0);
    __syncthreads();
    if (kt + 2 < nk) G_DMA(buf0, (kt + 2) * 64);
    G_COMPUTE(buf1);
    __syncthreads();
  }
#undef G_DMA
#undef G_COMPUTE
#undef G_FRAGS
#undef G_MMA
}


constexpr int K2_ST = 24576;
DEV void gemm_kloop256(const bf16_t* __restrict__ Wp, long ldw, const bf16_t* __restrict__ Xp, long ldx, int K,
                       f32x16 (&acc)[4][2], char* lds) {
  const int tid = tid_(), lane = tid & 63, wid = tid >> 6, wr = wid >> 1, wc = wid & 1;
  const int r = lane & 31, hh = lane >> 5;
  const int srow = tid >> 2, sc = (tid & 3) ^ ((tid >> 4) & 3);
  const bf16_t* wsrc = Wp + (long)srow * ldw + sc * 8;
  const bf16_t* xsrc = Xp + (long)srow * ldx + sc * 8;
  typedef __attribute__((address_space(3))) unsigned lds_u32;
  typedef const __attribute__((address_space(1))) unsigned glb_u32;
  char* dbase = lds + tid * 16;
#define G2_DMA(slot_, ko)                                                                                          \
  {                                                                                                                \
    char* _d = dbase + (slot_) * K2_ST;                                                                            \
    __builtin_amdgcn_global_load_lds((glb_u32*)(wsrc + (ko)), (lds_u32*)(_d), 16, 0, 0);                           \
    __builtin_amdgcn_global_load_lds((glb_u32*)(wsrc + (long)64 * ldw + (ko)), (lds_u32*)(_d + 4096), 16, 0, 0);   \
    __builtin_amdgcn_global_load_lds((glb_u32*)(wsrc + (long)128 * ldw + (ko)), (lds_u32*)(_d + 8192), 16, 0, 0);  \
    __builtin_amdgcn_global_load_lds((glb_u32*)(wsrc + (long)192 * ldw + (ko)), (lds_u32*)(_d + 12288), 16, 0, 0); \
    __builtin_amdgcn_global_load_lds((glb_u32*)(xsrc + (ko)), (lds_u32*)(_d + 16384), 16, 0, 0);                   \
    __builtin_amdgcn_global_load_lds((glb_u32*)(xsrc + (long)64 * ldx + (ko)), (lds_u32*)(_d + 20480), 16, 0, 0);  \
  }
  const int swz = (r >> 2) & 3;
  const int aoff = (wr * 128 + r) * 64;
  const int boff = 16384 + (wc * 64 + r) * 64;
  const int c0 = ((0 + hh) ^ swz) << 4, c1 = ((2 + hh) ^ swz) << 4;
#define G2_KK(cur, ck)                                                                               \
  {                                                                                                  \
    const bf16x8 a0 = *(const bf16x8*)((cur) + aoff + (ck));                                         \
    const bf16x8 a1 = *(const bf16x8*)((cur) + aoff + 2048 + (ck));                                  \
    const bf16x8 a2 = *(const bf16x8*)((cur) + aoff + 4096 + (ck));                                  \
    const bf16x8 a3 = *(const bf16x8*)((cur) + aoff + 6144 + (ck));                                  \
    const bf16x8 b0 = *(const bf16x8*)((cur) + boff + (ck));                                         \
    const bf16x8 b1 = *(const bf16x8*)((cur) + boff + 2048 + (ck));                                  \
    acc[0][0] = __builtin_amdgcn_mfma_f32_32x32x16_bf16(a0, b0, acc[0][0], 0, 0, 0);                 \
    acc[0][1] = __builtin_amdgcn_mfma_f32_32x32x16_bf16(a0, b1, acc[0][1], 0, 0, 0);                 \
    acc[1][0] = __builtin_amdgcn_mfma_f32_32x32x16_bf16(a1, b0, acc[1][0], 0, 0, 0);                 \
    acc[1][1] = __builtin_amdgcn_mfma_f32_32x32x16_bf16(a1, b1, acc[1][1], 0, 0, 0);                 \
    acc[2][0] = __builtin_amdgcn_mfma_f32_32x32x16_bf16(a2, b0, acc[2][0], 0, 0, 0);                 \
    acc[2][1] = __builtin_amdgcn_mfma_f32_32x32x16_bf16(a2, b1, acc[2][1], 0, 0, 0);                 \
    acc[3][0] = __builtin_amdgcn_mfma_f32_32x32x16_bf16(a3, b0, acc[3][0], 0, 0, 0);                 \
    acc[3][1] = __builtin_amdgcn_mfma_f32_32x32x16_bf16(a3, b1, acc[3][1], 0, 0, 0);                 \
  }
#define G2_SYNC()                                                  \
  asm volatile("s_waitcnt vmcnt(6) lgkmcnt(0)" ::: "memory");      \
  __builtin_amdgcn_s_barrier();                                    \
  asm volatile("" ::: "memory");
  const int n = K >> 5;
  const int klast = (n - 1) * 32;
  G2_DMA(0, 0);
  G2_DMA(1, 32);
  G2_SYNC();
  int slot = 0;
  for (int s = 0; s < n; ++s) {
    const int dslot = slot >= 1 ? slot - 1 : 2;
    const int k2 = (s + 2) * 32;
    G2_DMA(dslot, k2 < klast ? k2 : klast);
    const char* cur = lds + slot * K2_ST;
    __builtin_amdgcn_s_setprio(1);
    G2_KK(cur, c0);
    G2_KK(cur, c1);
    __builtin_amdgcn_s_setprio(0);
    G2_SYNC();
    slot = slot == 2 ? 0 : slot + 1;
  }
  asm volatile("s_waitcnt vmcnt(0)" ::: "memory");
  __builtin_amdgcn_s_barrier();
  asm volatile("" ::: "memory");
#undef G2_DMA
#undef G2_KK
#undef G2_SYNC
}

DEV void zero_acc4(f32x16 (&acc)[4][2]) {
#pragma unroll
  for (int a = 0; a < 4; ++a)
#pragma unroll
    for (int b = 0; b < 2; ++b)
#pragma unroll
      for (int i = 0; i < 16; ++i) acc[a][b][i] = 0.f;
}

DEV bool tile_coords(int L, int nM, int nN, int& pm, int& pn) {
  if (L >= nM * nN) return false;
  const int nig = 8 * nN, gid = L / nig, fm = gid * 8, gsz = (nM - fm) < 8 ? (nM - fm) : 8;
  pm = fm + (L % nig) % gsz;
  pn = (L % nig) / gsz;
  return true;
}
#define TILE_LOOP(nM, nN)                                                                   \
  for (int _it = 0, _nb = gridDim.x >> 3, _x = bid_() & 7, _j = bid_() >> 3, pm, pn; \
       tile_coords((_it * 8 + _x) * _nb + _j, (nM), (nN), pm, pn); ++_it)

DEV void zero_acc(f32x16 (&acc)[2][2]) {
#pragma unroll
  for (int a = 0; a < 2; ++a)
#pragma unroll
    for (int b = 0; b < 2; ++b)
#pragma unroll
      for (int i = 0; i < 16; ++i) acc[a][b][i] = 0.f;
}

DEV void norm_phase(const Params& p, const float* __restrict__ g, bf16_t* __restrict__ Hout, int mode) {
  const int lane = tid_() & 63;
  const int gw = (bid_() * blockDim.x + tid_()) >> 6, nw = (gridDim.x * blockDim.x) >> 6;
  for (int row = gw; row < M_; row += nw) {
    const int b = row / T_, t = row % T_;
    const float* src;
    if (mode == 0) src = p.X + (long)row * D_;
    else src = (t < PAD_) ? nullptr : (t < 128 ? p.meta + (long)(t - PAD_) * D_ : p.x + ((long)b * SEQ_ + (t - 128)) * D_);
    f32x4 v[8];
    float ss = 0.f;
#pragma unroll
    for (int i = 0; i < 8; ++i) {
      v[i] = src ? *(const f32x4*)(src + i * 256 + lane * 4) : (f32x4){0.f, 0.f, 0.f, 0.f};
      ss += v[i][0] * v[i][0] + v[i][1] * v[i][1] + v[i][2] * v[i][2] + v[i][3] * v[i][3];
    }
#pragma unroll
    for (int o = 32; o > 0; o >>= 1) ss += __shfl_xor(ss, o);
    const float rs = rsqrtf(ss * (1.0f / D_) + 1e-6f);
#pragma unroll
    for (int i = 0; i < 8; ++i) {
      const f32x4 gg = *(const f32x4*)(g + i * 256 + lane * 4);
      if (mode == 1) *(f32x4*)(p.X + (long)row * D_ + i * 256 + lane * 4) = v[i];
      uint2 o;
      o.x = pk_bf16(v[i][0] * rs * gg[0], v[i][1] * rs * gg[1]);
      o.y = pk_bf16(v[i][2] * rs * gg[2], v[i][3] * rs * gg[3]);
      *(uint2*)(Hout + (long)row * D_ + i * 256 + lane * 4) = o;
    }
  }
}

DEV void final_norm_phase(const Params& p) {
  const int lane = tid_() & 63;
  const int gw = (bid_() * blockDim.x + tid_()) >> 6, nw = (gridDim.x * blockDim.x) >> 6;
  for (int orow = gw; orow < 2 * SEQ_; orow += nw) {
    const int b = orow / SEQ_, t = orow % SEQ_;
    const float* src = p.X + ((long)b * T_ + 128 + t) * D_;
    f32x4 v[8];
    float ss = 0.f;
#pragma unroll
    for (int i = 0; i < 8; ++i) {
      v[i] = *(const f32x4*)(src + i * 256 + lane * 4);
      ss += v[i][0] * v[i][0] + v[i][1] * v[i][1] + v[i][2] * v[i][2] + v[i][3] * v[i][3];
    }
#pragma unroll
    for (int o = 32; o > 0; o >>= 1) ss += __shfl_xor(ss, o);
    const float rs = rsqrtf(ss * (1.0f / D_) + 1e-6f);
#pragma unroll
    for (int i = 0; i < 8; ++i) {
      const f32x4 gg = *(const f32x4*)(p.final_norm + i * 256 + lane * 4);
      f32x4 o = {v[i][0] * rs * gg[0], v[i][1] * rs * gg[1], v[i][2] * rs * gg[2], v[i][3] * rs * gg[3]};
      *(f32x4*)(p.out + (long)orow * D_ + i * 256 + lane * 4) = o;
    }
  }
}

DEV void conv_ffn(const Params& p, const float* w1, const float* w3, const float* w2, char* lds) {
  conv_t(p.W13, 2 * DFF, D_, [=](int n, long& ld) -> const float* {
    ld = DFF;
    const int tile = n >> 7, o = n & 127, wr = o >> 6, sub = (o & 63) >> 5, f = tile * 64 + wr * 32 + (o & 31);
    return (sub ? w3 : w1) + f;
  }, lds);
  conv_t(p.W2t, D_, DFF, [=](int n, long& ld) -> const float* { ld = D_; return w2 + n; }, lds);
}

DEV void ffn_up_phase(const Params& p, char* lds) {
  const int lane = tid_() & 63, wid = tid_() >> 6, wr = wid >> 1, wc = wid & 1, r = lane & 31, hh = lane >> 5;
  constexpr int ES = 144;
  char* stg = lds + wid * (64 * ES);
  TILE_LOOP(130, 44) {
    f32x16 acc[4][2];
    zero_acc4(acc);
    gemm_kloop256(p.W13 + (long)pn * 256 * D_, D_, p.H + (long)pm * 128 * D_, D_, D_, acc, lds);
    const int grp = pn * 2 + wr;
#pragma unroll
    for (int ni = 0; ni < 2; ++ni)
#pragma unroll
      for (int hp = 0; hp < 2; ++hp)
#pragma unroll
        for (int q = 0; q < 4; ++q) {
          float o[4];
#pragma unroll
          for (int e = 0; e < 4; ++e) {
            const float gte = acc[2 * hp][ni][4 * q + e], up = acc[2 * hp + 1][ni][4 * q + e];
            o[e] = gte / (1.f + __expf(-gte)) * up;
          }
          uint2 w;
          w.x = pk_bf16(o[0], o[1]);
          w.y = pk_bf16(o[2], o[3]);
          *(uint2*)(stg + (ni * 32 + r) * ES + (hp * 32 + 8 * q + 4 * hh) * 2) = w;
        }
    asm volatile("s_waitcnt lgkmcnt(0)" ::: "memory");
    {
      const int trow = lane >> 3, ch = lane & 7;
      bf16_t* dst = p.HID + ((long)pm * 128 + wc * 64 + trow) * DFF + grp * 64 + ch * 8;
#pragma unroll
      for (int i = 0; i < 8; ++i) {
        const uint4 v = *(const uint4*)(stg + (trow + 8 * i) * ES + ch * 16);
        *(uint4*)(dst + (long)(8 * i) * DFF) = v;
      }
    }
    __syncthreads();
  }
}

DEV void resid_gemm_phase(const Params& p, const bf16_t* Wt, const bf16_t* A, int K, float alpha, char* lds) {
  const int lane = tid_() & 63, wid = tid_() >> 6, wr = wid >> 1, wc = wid & 1, r = lane & 31, hh = lane >> 5;
  TILE_LOOP(130, 16) {
    f32x16 acc[2][2];
    zero_acc(acc);
    gemm_kloop(Wt + (long)pn * 128 * K, K, A + (long)pm * 128 * K, K, K, acc, lds);
    {
      constexpr int RS = 272;
      char* stg = lds + wid * (64 * RS);
#pragma unroll
      for (int mi = 0; mi < 2; ++mi)
#pragma unroll
        for (int ni = 0; ni < 2; ++ni)
#pragma unroll
          for (int q = 0; q < 4; ++q)
            *(f32x4*)(stg + (ni * 32 + r) * RS + (mi * 32 + 8 * q + 4 * hh) * 4) =
                (f32x4){acc[mi][ni][4 * q], acc[mi][ni][4 * q + 1], acc[mi][ni][4 * q + 2], acc[mi][ni][4 * q + 3]};
      asm volatile("s_waitcnt lgkmcnt(0)" ::: "memory");
      const int trow = lane >> 4, ch = lane & 15;
      float* xp = p.X + ((long)pm * 128 + wc * 64 + trow) * D_ + pn * 128 + wr * 64 + ch * 4;
#pragma unroll
      for (int i = 0; i < 16; ++i) {
        const f32x4 u = *(const f32x4*)(stg + (trow + 4 * i) * RS + ch * 16);
        f32x4* px = (f32x4*)(xp + (long)(4 * i) * D_);
        f32x4 v = *px;
        v += alpha * u;
        *px = v;
      }
      __syncthreads();
    }
  }
}


DEV void fold_phase(const Params& p, int l, int mode, char* ldsraw) {
  float (*P)[129] = (float (*)[129])ldsraw;
  float (*Q)[129] = (float (*)[129])(ldsraw + 64 * 129 * 4);
  const int tid = tid_();
  const float* w_in = p.w_in + (long)l * D_ * DIN;
  const float* w_uk = p.w_uk + (long)l * 256 * 1024;
  const float* w_uv = p.w_uv + (long)l * 256 * 1024;
  const float* wb0 = p.w_branch + (long)l * 3 * 1024 * D_;
  const int nI = mode == 0 ? 4 : 32, nJ = mode == 0 ? 32 : 4;
  for (int u = bid_(); u < 8 * nI * nJ; u += gridDim.x) {
    const int h = u / (nI * nJ), i0 = ((u / nJ) % nI) * 64, j0 = (u % nJ) * 64;
    if (mode == 0) {
      const int d = tid & 127, rb = tid >> 7;
#pragma unroll 4
      for (int it = 0; it < 32; ++it) {
        const int row = rb + 2 * it;
        P[row][d] = w_uk[((long)(i0 + row) * 8 + h) * 128 + d];
        Q[row][d] = w_in[(long)(j0 + row) * DIN + h * 128 + d];
      }
    } else {
      const int d = tid & 127, rb = tid >> 7;
#pragma unroll 4
      for (int it = 0; it < 32; ++it) {
        const int row = rb + 2 * it;
        Q[row][d] = w_uv[((long)(j0 + row) * 8 + h) * 128 + d];
      }
      const int ii = tid & 63, db = tid >> 6;
#pragma unroll 4
      for (int it = 0; it < 32; ++it) {
        const int dd = db + 4 * it;
        P[ii][dd] = wb0[(long)(h * 128 + dd) * D_ + i0 + ii];
      }
    }
    __syncthreads();
    const int ti = tid >> 4, tj = tid & 15;
    float o[4][4];
#pragma unroll
    for (int a = 0; a < 4; ++a)
#pragma unroll
      for (int b = 0; b < 4; ++b) o[a][b] = 0.f;
#pragma unroll 4
    for (int d = 0; d < 128; ++d) {
      float pa[4], qb[4];
#pragma unroll
      for (int a = 0; a < 4; ++a) { pa[a] = P[ti * 4 + a][d]; qb[a] = Q[tj * 4 + a][d]; }
#pragma unroll
      for (int a = 0; a < 4; ++a)
#pragma unroll
        for (int b = 0; b < 4; ++b) o[a][b] += pa[a] * qb[b];
    }
    const float sc = mode == 0 ? 0.08838834764831845f * 1.4426950408889634f : 1.0f;
#pragma unroll
    for (int a = 0; a < 4; ++a) {
      uint2 w;
      w.x = pk_bf16(o[a][0] * sc, o[a][1] * sc);
      w.y = pk_bf16(o[a][2] * sc, o[a][3] * sc);
      if (mode == 0) *(uint2*)(p.Wint + (long)(h * 256 + i0 + ti * 4 + a) * D_ + j0 + tj * 4) = w;
      else *(uint2*)(p.Wb0 + (long)(i0 + ti * 4 + a) * 2048 + h * 256 + j0 + tj * 4) = w;
    }
    __syncthreads();
  }
}

DEV void conv_mixer(const Params& p, int l, char* lds) {
  const float* w_in = p.w_in + (long)l * D_ * DIN;
  fold_phase(p, l, 0, lds);
  fold_phase(p, l, 1, lds);
  conv_t(p.Wint + (long)2048 * D_, NIN - 2048, D_, [=](int n, long& ld) -> const float* {
    ld = DIN;
    n += 2048;
    int c;
    if (n < 2304) c = 1024 + (n - 2048);
    else if (n < 3328) c = 1280 + (n - 2304);
    else if (n < 3456) { const int o = n - 3328; c = o < 64 ? 2304 + o : (o < 80 ? 2368 + (o - 64) : (o < 88 ? 5456 + (o - 80) : -1)); }
    else if (n < 4480) c = 2384 + (n - 3456);
    else if (n < 5504) c = 3408 + (n - 4480);
    else if (n < 6528) c = 4432 + (n - 5504);
    else if (n < 7040) c = 5464 + (n - 6528);
    else if (n < 7552) c = 5976 + (n - 7040);
    else if (n < 8576) c = 6488 + (n - 7552);
    else if (n < 9600) c = 7512 + (n - 8576);
    else c = -1;
    return c < 0 ? nullptr : w_in + c;
  }, lds);
  conv_t(p.Wgt, 6144, D_, [=](int n, long& ld) -> const float* { ld = DIN; return w_in + 8536 + n; }, lds);
  const float* wb = p.w_branch + (long)l * 3 * 1024 * D_;
  conv_t(p.Wb1, D_, 1024, [=](int n, long& ld) -> const float* { ld = D_; return wb + (long)1024 * D_ + n; }, lds);
  conv_t(p.Wb2, D_, 1024, [=](int n, long& ld) -> const float* { ld = D_; return wb + (long)2 * 1024 * D_ + n; }, lds);
  const float* wo = p.w_out + (long)l * D_ * D_;
  conv_t(p.Wot, D_, D_, [=](int n, long& ld) -> const float* { ld = D_; return wo + n; }, lds);
}

DEV void rope_table_phase(const Params& p) {
  const int gt = bid_() * blockDim.x + tid_(), nt = gridDim.x * blockDim.x;
  for (int e = gt; e < T_ * 32; e += nt) {
    const int t = e >> 5, i = e & 31;
    const float inv = fexp2(-(float)i * (13.287712379549449f / 32.0f));
    const float ang = (float)t * inv;
    const float k = rintf(ang * 0.15915494309189535f);
    float rr = fmaf(-k, 6.28318548202514648f, ang);
    rr = fmaf(-k, -1.74845553146951715e-07f, rr);
    p.ROPE[t * 64 + i] = __cosf(rr);
    p.ROPE[t * 64 + 32 + i] = __sinf(rr);
  }
}

DEV void proj_phase(const Params& p, char* lds) {
  const int lane = tid_() & 63, wid = tid_() >> 6, wr = wid >> 1, wc = wid & 1, r = lane & 31, hh = lane >> 5;
  TILE_LOOP(130, 38) {
    f32x16 acc[4][2];
    zero_acc4(acc);
    gemm_kloop256(p.Wint + (long)pn * 256 * D_, D_, p.H + (long)pm * 128 * D_, D_, D_, acc, lds);
    const int sn = pn * 2 + wr;
    const bool plain = sn < 26 || (sn >= 27 && sn <= 42) || (sn >= 67 && sn <= 74);
    if (plain) {
      int col; float sc = 1.f;
      if (sn < 16) col = sn * 128;
      else if (sn < 18) col = 2048 + (sn - 16) * 128;
      else if (sn < 26) { col = 2304 + (sn - 18) * 128; sc = 0.125f; }
      else if (sn < 35) { col = 3328 + (sn - 27) * 128; sc = 0.08838834764831845f * 1.4426950408889634f; }
      else if (sn < 43) col = 4352 + (sn - 35) * 128;
      else col = 6400 + (sn - 67) * 128;
      constexpr int PS = 272;
      char* stg = lds + wid * (64 * PS);
#pragma unroll
      for (int mi = 0; mi < 4; ++mi)
#pragma unroll
        for (int ni = 0; ni < 2; ++ni)
#pragma unroll
          for (int q = 0; q < 4; ++q) {
            uint2 w;
            w.x = pk_bf16(acc[mi][ni][4 * q] * sc, acc[mi][ni][4 * q + 1] * sc);
            w.y = pk_bf16(acc[mi][ni][4 * q + 2] * sc, acc[mi][ni][4 * q + 3] * sc);
            *(uint2*)(stg + (ni * 32 + r) * PS + (mi * 32 + 8 * q + 4 * hh) * 2) = w;
          }
      asm volatile("s_waitcnt lgkmcnt(0)" ::: "memory");
      const int trow = lane >> 4, ch = lane & 15;
      bf16_t* dst = p.PROJ + ((long)pm * 128 + wc * 64 + trow) * LDP + col + ch * 8;
#pragma unroll
      for (int i = 0; i < 16; ++i) *(uint4*)(dst + (long)(4 * i) * LDP) = *(const uint4*)(stg + (trow + 4 * i) * PS + ch * 16);
    } else if (sn >= 75) {
    } else if (sn >= 51 && sn <= 58) {
      const bool isk = sn >= 55;
#pragma unroll
      for (int hs = 0; hs < 2; ++hs) {
        const int head = (isk ? sn - 55 : sn - 51) * 2 + hs;
#pragma unroll
        for (int ni = 0; ni < 2; ++ni) {
          const long tok = (long)pm * 128 + wc * 64 + ni * 32 + r;
          const int b = (int)(tok / T_), t = (int)(tok % T_);
          const float ksc = isk ? (t >= PAD_ ? 0.125f : 0.f) : 1.f;
#pragma unroll
          for (int q = 0; q < 4; ++q) {
            const int i = 8 * q + 4 * hh;
            const f32x4 cs = *(const f32x4*)(p.ROPE + t * 64 + i), sn4 = *(const f32x4*)(p.ROPE + t * 64 + 32 + i);
            float y1[4], y2[4];
#pragma unroll
            for (int e = 0; e < 4; ++e) {
              const float x1 = acc[2 * hs][ni][4 * q + e], x2 = acc[2 * hs + 1][ni][4 * q + e];
              y1[e] = (x1 * cs[e] - x2 * sn4[e]) * ksc;
              y2[e] = (x1 * sn4[e] + x2 * cs[e]) * ksc;
            }
            uint2 w1, w2;
            w1.x = pk_bf16(y1[0], y1[1]); w1.y = pk_bf16(y1[2], y1[3]);
            w2.x = pk_bf16(y2[0], y2[1]); w2.y = pk_bf16(y2[2], y2[3]);
            const int col = (isk ? 5888 : 5376) + head * 64 + i;
            *(uint2*)(p.PROJ + tok * LDP + col) = w1;
            *(uint2*)(p.PROJ + tok * LDP + col + 32) = w2;
            if (isk) {
              bf16_t* kt = p.RKT + ((long)(b * 8 + head) * 64 + i) * T_ + t;
              kt[0] = (bf16_t)(w1.x & 0xffff); kt[T_] = (bf16_t)(w1.x >> 16); kt[2 * T_] = (bf16_t)(w1.y & 0xffff); kt[3 * T_] = (bf16_t)(w1.y >> 16);
              kt[(long)32 * T_] = (bf16_t)(w2.x & 0xffff); kt[(long)33 * T_] = (bf16_t)(w2.x >> 16);
              kt[(long)34 * T_] = (bf16_t)(w2.y & 0xffff); kt[(long)35 * T_] = (bf16_t)(w2.y >> 16);
            }
          }
        }
      }
    } else {
#pragma unroll
      for (int mi = 0; mi < 4; ++mi)
#pragma unroll
        for (int ni = 0; ni < 2; ++ni) {
          const long tok = (long)pm * 128 + wc * 64 + ni * 32 + r;
          const int b = (int)(tok / T_), t = (int)(tok % T_);
#pragma unroll
          for (int q = 0; q < 4; ++q) {
            const int fl = mi * 32 + 8 * q + 4 * hh;
            float v[4];
#pragma unroll
            for (int e = 0; e < 4; ++e) v[e] = acc[mi][ni][4 * q + e];
            if (sn == 26) {
              *(f32x4*)(p.SMALL + tok * 128 + fl) = (f32x4){v[0], v[1], v[2], v[3]};
              if (fl < 64) { uint2 w; w.x = pk_bf16(v[0], v[1]); w.y = pk_bf16(v[2], v[3]); *(uint2*)(p.IK16 + tok * 64 + fl) = w; }
            } else if ((sn >= 43 && sn <= 50) || (sn >= 59 && sn <= 66)) {
              const bool isf = sn <= 50;
              const int hd = isf ? sn - 43 : sn - 59;
              bf16_t* dst = (isf ? p.FVT : p.RVT) + ((long)(b * 8 + hd) * 128 + fl) * T_ + t;
              const unsigned a = pk_bf16(v[0], v[1]), c = pk_bf16(v[2], v[3]);
              dst[0] = (bf16_t)(a & 0xffff); dst[T_] = (bf16_t)(a >> 16); dst[2 * T_] = (bf16_t)(c & 0xffff); dst[3 * T_] = (bf16_t)(c >> 16);
            } else {
              int col; float sc = 1.f;
              if (sn < 16) col = sn * 128;
              else if (sn < 18) col = 2048 + (sn - 16) * 128;
              else if (sn < 26) { col = 2304 + (sn - 18) * 128; sc = 0.125f; }
              else if (sn < 35) { col = 3328 + (sn - 27) * 128; sc = 0.08838834764831845f * 1.4426950408889634f; }
              else if (sn < 43) col = 4352 + (sn - 35) * 128;
              else col = 6400 + (sn - 67) * 128;
              uint2 w; w.x = pk_bf16(v[0] * sc, v[1] * sc); w.y = pk_bf16(v[2] * sc, v[3] * sc);
              *(uint2*)(p.PROJ + tok * LDP + col + fl) = w;
            }
          }
        }
    }
    __syncthreads();
  }
}

DEV bf16x8 ld_frag16(const bf16_t* ptr) { return *(const bf16x8*)ptr; }
DEV float log2gamma(int hd) { return __log2f(1.0f - fexp2(-5.0f - (float)hd)); }

DEV void ret_kv_phase(const Params& p) {
  const int lane = tid_() & 63, r = lane & 31, hh = lane >> 5;
  const int gw = (bid_() * blockDim.x + tid_()) >> 6, nw = (gridDim.x * blockDim.x) >> 6;
  for (int u = gw; u < 2 * NCH * 8 * 2; u += nw) {
    const int dvh = u & 1, hd = (u >> 1) & 7, n = (u >> 4) % NCH, b = u / (16 * NCH);
    const float lg = log2gamma(hd);
    f32x16 acc[2][2];
    zero_acc(acc);
    const bf16_t* vt = p.RVT + ((long)(b * 8 + hd) * 128 + dvh * 64 + r) * T_ + n * 128 + 8 * hh;
    const bf16_t* kt = p.RKT + ((long)(b * 8 + hd) * 64 + r) * T_ + n * 128 + 8 * hh;
#pragma unroll 2
    for (int ks = 0; ks < 8; ++ks) {
      const bf16x8 a0 = ld_frag16(vt + ks * 16), a1 = ld_frag16(vt + (long)32 * T_ + ks * 16);
      bf16x8 kb[2];
#pragma unroll
      for (int nt = 0; nt < 2; ++nt) {
        const uint4 raw = *(const uint4*)(kt + (long)nt * 32 * T_ + ks * 16);
        const unsigned rw[4] = {raw.x, raw.y, raw.z, raw.w};
        unsigned o[4];
#pragma unroll
        for (int e = 0; e < 4; ++e) {
          const int j = ks * 16 + 8 * hh + 2 * e;
          const float d0 = fexp2((float)(127 - j) * lg), d1 = fexp2((float)(126 - j) * lg);
          o[e] = pk_bf16(bflo(rw[e]) * d0, bfhi(rw[e]) * d1);
        }
        union { uint4 u; bf16x8 v; } cv; cv.u = make_uint4(o[0], o[1], o[2], o[3]);
        kb[nt] = cv.v;
      }
      acc[0][0] = __builtin_amdgcn_mfma_f32_32x32x16_bf16(a0, kb[0], acc[0][0], 0, 0, 0);
      acc[0][1] = __builtin_amdgcn_mfma_f32_32x32x16_bf16(a0, kb[1], acc[0][1], 0, 0, 0);
      acc[1][0] = __builtin_amdgcn_mfma_f32_32x32x16_bf16(a1, kb[0], acc[1][0], 0, 0, 0);
      acc[1][1] = __builtin_amdgcn_mfma_f32_32x32x16_bf16(a1, kb[1], acc[1][1], 0, 0, 0);
    }
    float* dst = p.KV + ((long)(n * 2 + b) * 8 + hd) * 8192;
#pragma unroll
    for (int mt = 0; mt < 2; ++mt)
#pragma unroll
      for (int nt = 0; nt < 2; ++nt)
#pragma unroll
        for (int reg = 0; reg < 16; ++reg) {
          const int dv = dvh * 64 + mt * 32 + (reg & 3) + 8 * (reg >> 2) + 4 * hh;
          dst[dv * 64 + nt * 32 + r] = acc[mt][nt][reg];
        }
  }
}

DEV void ret_scan_phase(const Params& p) {
  const int gt = bid_() * blockDim.x + tid_(), nt = gridDim.x * blockDim.x;
  for (int e = gt; e < 131072; e += nt) {
    const int hd = (e >> 13) & 7;
    const float cd = fexp2(128.0f * log2gamma(hd));
    float s = 0.f;
    float* base = p.KV + e;
    for (int n0 = 0; n0 < NCH; n0 += 13) {
      float v[13];
#pragma unroll
      for (int i = 0; i < 13; ++i) v[i] = base[(long)(n0 + i) * 131072];
#pragma unroll
      for (int i = 0; i < 13; ++i) { base[(long)(n0 + i) * 131072] = s; s = cd * s + v[i]; }
    }
  }
}

DEV void ret_out_phase(const Params& p, const float* gw_) {
  const int lane = tid_() & 63, r = lane & 31, hh = lane >> 5;
  const int gw = (bid_() * blockDim.x + tid_()) >> 6, nw = (gridDim.x * blockDim.x) >> 6;
  for (int u = gw; u < 2 * NCH * 8 * 4; u += nw) {
    const int w = u & 3, hd = (u >> 2) & 7, n = (u >> 5) % NCH, b = u / (32 * NCH);
    const float lg = log2gamma(hd);
    const long tok = (long)b * T_ + n * 128 + w * 32 + r;
    bf16x8 qf[4];
#pragma unroll
    for (int ks = 0; ks < 4; ++ks) qf[ks] = ld_frag16(p.PROJ + tok * LDP + 5376 + hd * 64 + ks * 16 + 8 * hh);
    f32x16 O[4];
#pragma unroll
    for (int mt = 0; mt < 4; ++mt)
#pragma unroll
      for (int i = 0; i < 16; ++i) O[mt][i] = 0.f;
    const float* st = p.ST + ((long)(n * 2 + b) * 8 + hd) * 8192;
#pragma unroll
    for (int mt = 0; mt < 4; ++mt)
#pragma unroll
      for (int ks = 0; ks < 4; ++ks) {
        const float* sp = st + (mt * 32 + r) * 64 + ks * 16 + 8 * hh;
        const f32x4 s0 = *(const f32x4*)sp, s1 = *(const f32x4*)(sp + 4);
        union { uint4 u; bf16x8 v; } cv;
        cv.u = make_uint4(pk_bf16(s0[0], s0[1]), pk_bf16(s0[2], s0[3]), pk_bf16(s1[0], s1[1]), pk_bf16(s1[2], s1[3]));
        O[mt] = __builtin_amdgcn_mfma_f32_32x32x16_bf16(cv.v, qf[ks], O[mt], 0, 0, 0);
      }
    {
      const float qd = fexp2((float)(w * 32 + r + 1) * lg);
#pragma unroll
      for (int mt = 0; mt < 4; ++mt)
#pragma unroll
        for (int i = 0; i < 16; ++i) O[mt][i] *= qd;
    }
    for (int jt = 0; jt <= w; ++jt) {
      f32x16 s;
#pragma unroll
      for (int i = 0; i < 16; ++i) s[i] = 0.f;
      const bf16_t* kp = p.PROJ + ((long)b * T_ + n * 128 + jt * 32 + r) * LDP + 5888 + hd * 64 + 8 * hh;
#pragma unroll
      for (int ks = 0; ks < 4; ++ks) s = __builtin_amdgcn_mfma_f32_32x32x16_bf16(ld_frag16(kp + ks * 16), qf[ks], s, 0, 0, 0);
      const int ii = w * 32 + r;
      unsigned pw[8];
#pragma unroll
      for (int e = 0; e < 8; ++e) {
        float v2[2];
#pragma unroll
        for (int z = 0; z < 2; ++z) {
          const int reg = 2 * e + z;
          const int j = jt * 32 + (reg & 3) + 8 * (reg >> 2) + 4 * hh;
          v2[z] = (ii >= j) ? s[reg] * fexp2((float)(ii - j) * lg) : 0.f;
        }
        pw[e] = pk_bf16(v2[0], v2[1]);
      }
#pragma unroll
      for (int s2 = 0; s2 < 2; ++s2) {
        union { uint4 u; bf16x8 v; } pb;
        pb.u = make_uint4(pw[4 * s2], pw[4 * s2 + 1], pw[4 * s2 + 2], pw[4 * s2 + 3]);
#pragma unroll
        for (int mt = 0; mt < 4; ++mt) {
          const bf16_t* vp = p.RVT + ((long)(b * 8 + hd) * 128 + mt * 32 + r) * T_ + n * 128 + jt * 32 + 16 * s2 + 4 * hh;
          const uint2 lo = *(const uint2*)vp, hi = *(const uint2*)(vp + 8);
          union { uint4 u; bf16x8 v; } av; av.u = make_uint4(lo.x, lo.y, hi.x, hi.y);
          O[mt] = __builtin_amdgcn_mfma_f32_32x32x16_bf16(av.v, pb.v, O[mt], 0, 0, 0);
        }
      }
    }
    float sum = 0.f;
#pragma unroll
    for (int mt = 0; mt < 4; ++mt)
#pragma unroll
      for (int i = 0; i < 16; ++i) sum += O[mt][i];
    sum += __shfl_xor(sum, 32);
    const float mu = sum * (1.0f / 128.0f);
    float vs = 0.f;
#pragma unroll
    for (int mt = 0; mt < 4; ++mt)
#pragma unroll
      for (int i = 0; i < 16; ++i) { const float d = O[mt][i] - mu; vs += d * d; }
    vs += __shfl_xor(vs, 32);
    const float rstd = rsqrtf(vs * (1.0f / 128.0f) + 1e-5f);
#pragma unroll
    for (int mt = 0; mt < 4; ++mt)
#pragma unroll
      for (int q = 0; q < 4; ++q) {
        const int dv = mt * 32 + 8 * q + 4 * hh;
        const uint2 g2 = *(const uint2*)(p.PROJ + tok * LDP + 6400 + hd * 128 + dv);
        const f32x4 gw4 = *(const f32x4*)(gw_ + hd * 128 + dv);
        const float g[4] = {bflo(g2.x), bfhi(g2.x), bflo(g2.y), bfhi(g2.y)};
        float o[4];
#pragma unroll
        for (int e = 0; e < 4; ++e) {
          const float nv = (O[mt][4 * q + e] - mu) * rstd * gw4[e];
          o[e] = g[e] / (1.f + __expf(-g[e])) * nv;
        }
        uint2 wv; wv.x = pk_bf16(o[0], o[1]); wv.y = pk_bf16(o[2], o[3]);
        *(uint2*)(p.BR + tok * LDB + 3072 + hd * 128 + dv) = wv;
      }
  }
}


DEV void fox_cum_phase(const Params& p, const float* fbias) {
  const int lane = tid_() & 63;
  const int gw = (bid_() * blockDim.x + tid_()) >> 6, nw = (gridDim.x * blockDim.x) >> 6;
  for (int u = gw; u < 16; u += nw) {
    const int b = u >> 3, h = u & 7;
    const float fb = fbias[h];
    const float* src = p.SMALL + ((long)b * T_ + lane * 130) * 128 + 80 + h;
    float loc = 0.f;
    for (int i = 0; i < 130; ++i) {
      const int t = lane * 130 + i;
      const float z = src[(long)i * 128] + fb;
      const float lf = fminf(z, 0.f) - __logf(1.f + __expf(-fabsf(z)));
      loc += (t >= PAD_) ? lf : 0.f;
    }
    float inc = loc;
#pragma unroll
    for (int o = 1; o < 64; o <<= 1) { const float n = __shfl_up(inc, o); if (lane >= o) inc += n; }
    float run = inc - loc;
    float* dst = p.CUM + ((long)b * T_ + lane * 130) * 8 + h;
    for (int i = 0; i < 130; ++i) {
      const int t = lane * 130 + i;
      const float z = src[(long)i * 128] + fb;
      const float lf = fminf(z, 0.f) - __logf(1.f + __expf(-fabsf(z)));
      run += (t >= PAD_) ? lf : 0.f;
      dst[(long)i * 8] = run * 1.4426950408889634f;
    }
  }
}


DEV void fox_norm_phase(const Params& p) {
  const int lane = tid_() & 63;
  const int gw = (bid_() * blockDim.x + tid_()) >> 6, nw = (gridDim.x * blockDim.x) >> 6;
  for (int u = gw; u < 16 * NCH; u += nw) {
    const int bh = u / NCH, c = u % NCH, b = bh >> 3, h = bh & 7;
    float qm = 0.f, km = 0.f;
#pragma unroll
    for (int s = 0; s < 2; ++s) {
      const long row = (long)b * T_ + c * 128 + s * 64 + lane;
      float qs = 0.f, ks = 0.f;
#pragma unroll
      for (int i = 0; i < 16; ++i) {
        const uint4 qv = *(const uint4*)(p.PROJ + row * LDP + 3328 + h * 128 + i * 8);
        const uint4 kv = *(const uint4*)(p.PROJ + row * LDP + 4352 + h * 128 + i * 8);
        const unsigned qw[4] = {qv.x, qv.y, qv.z, qv.w}, kw[4] = {kv.x, kv.y, kv.z, kv.w};
#pragma unroll
        for (int e = 0; e < 4; ++e) {
          qs += bflo(qw[e]) * bflo(qw[e]) + bfhi(qw[e]) * bfhi(qw[e]);
          ks += bflo(kw[e]) * bflo(kw[e]) + bfhi(kw[e]) * bfhi(kw[e]);
        }
      }
      qm = fmaxf(qm, qs);
      km = fmaxf(km, ks);
    }
#pragma unroll
    for (int o = 32; o > 0; o >>= 1) { qm = fmaxf(qm, __shfl_xor(qm, o)); km = fmaxf(km, __shfl_xor(km, o)); }
    if (lane == 0) { p.QN[u] = sqrtf(qm) * 1.0001f; p.KN[u] = sqrtf(km) * 1.0001f; }
  }
}

DEV int pop_unit(unsigned* ctr, char* lds) {
  volatile int* slot = (volatile int*)(lds + LDS_BYTES - 16);
  __syncthreads();
  if (tid_() == 0) *slot = (int)atomicAdd(ctr, 1u);
  __syncthreads();
  return *slot;
}

constexpr int FK_S = 272, FV_S = 136;
constexpr int FOX_BUF = 64 * FK_S + 128 * FV_S + 256;
DEV void fox_unit(const Params& p, int b, int h, int qt, char* lds) {
  const int tid = tid_(), lane = tid & 63, w = tid >> 6, r = lane & 31, hh = lane >> 5;
  const int q0 = qt * 128;
  const int qpos = q0 + w * 32 + r;
  const long qrow = (long)b * T_ + qpos;
  bf16x8 qf[8];
#pragma unroll
  for (int kk = 0; kk < 8; ++kk) qf[kk] = *(const bf16x8*)(p.PROJ + qrow * LDP + 3328 + h * 128 + kk * 16 + 8 * hh);
  const float cq = p.CUM[qrow * 8 + h];
  f32x16 O[4];
#pragma unroll
  for (int mt = 0; mt < 4; ++mt)
#pragma unroll
    for (int i = 0; i < 16; ++i) O[mt][i] = 0.f;
  float m = -1e30f, lsum = 0.f;
  const int nt = 2 * qt + 1;
  int t_start;
  {
    const int bh = b * 8 + h;
    float kall = 0.f;
    for (int c = lane; c <= qt; c += 64) kall = fmaxf(kall, p.KN[bh * NCH + c]);
#pragma unroll
    for (int o = 32; o > 0; o >>= 1) kall = fmaxf(kall, __shfl_xor(kall, o));
    const float bound = 2.f * p.QN[bh * NCH + qt] * kall + 150.f;
    const int qfirst = q0 < PAD_ ? PAD_ : q0;
    const float lim = p.CUM[((long)b * T_ + qfirst) * 8 + h] + bound;
    int first = nt;
    for (int t0 = 0; t0 < nt; t0 += 64) {
      const int t = t0 + lane;
      const bool keep = (t < nt) && (p.CUM[((long)b * T_ + 64 + t * 64 + 63) * 8 + h] <= lim);
      const unsigned long long mk = __ballot(keep);
      if (mk) { first = t0 + __ffsll((long long)mk) - 1; break; }
    }
    const int tcap = 2 * qt - 1 > 0 ? 2 * qt - 1 : 0;
    t_start = first < tcap ? first : tcap;
  }
  const bf16_t* kbase = p.PROJ + ((long)b * T_) * LDP + 4352 + h * 128;
  const bf16_t* vbase = p.FVT + ((long)(b * 8 + h) * 128) * T_;
  const float* cbase = p.CUM + ((long)b * T_) * 8 + h;
  uint4 kr0, kr1, kr2, kr3, vr0, vr1, vr2, vr3;
  float cr = 0.f;
#define FOX_GL1(i, k0_)                                                                        \
  {                                                                                            \
    const int c = tid + 256 * (i);                                                             \
    kr##i = *(const uint4*)(kbase + (long)((k0_) + (c >> 4)) * LDP + (c & 15) * 8);            \
    vr##i = *(const uint4*)(vbase + (long)(c >> 3) * T_ + (k0_) + (c & 7) * 8);                \
  }
#define FOX_GLOAD(k0_)                                                                         \
  {                                                                                            \
    FOX_GL1(0, k0_) FOX_GL1(1, k0_) FOX_GL1(2, k0_) FOX_GL1(3, k0_)                            \
    if (tid < 64) cr = cbase[(long)((k0_) + tid) * 8];                                         \
  }
#define FOX_LS1(i, buf)                                                                        \
  {                                                                                            \
    const int c = tid + 256 * (i);                                                             \
    *(uint4*)(buf + (c >> 4) * FK_S + (c & 15) * 16) = kr##i;                                  \
    char* vd = buf + 64 * FK_S + (c >> 3) * FV_S + (c & 7) * 16;                               \
    *(uint2*)vd = make_uint2(vr##i.x, vr##i.y);                                                \
    *(uint2*)(vd + 8) = make_uint2(vr##i.z, vr##i.w);                                          \
  }
#define FOX_LSTORE(buf_)                                                                       \
  {                                                                                            \
    char* buf = (buf_);                                                                        \
    FOX_LS1(0, buf) FOX_LS1(1, buf) FOX_LS1(2, buf) FOX_LS1(3, buf)                            \
    if (tid < 64) *(float*)(buf + 64 * FK_S + 128 * FV_S + tid * 4) = cr;                      \
  }
  FOX_GLOAD(64 + t_start * 64);
  FOX_LSTORE(lds + (t_start & 1) * FOX_BUF);
  __syncthreads();
  const int qwmax = q0 + w * 32 + 31;
  for (int t = t_start; t < nt; ++t) {
    const int k0 = 64 + t * 64;
    char* cur = lds + (t & 1) * FOX_BUF;
    const bool more = (t + 1) < nt;
    if (more) FOX_GLOAD(k0 + 64);
    if (k0 <= qwmax) {
      f32x16 s[2];
#pragma unroll
      for (int k2 = 0; k2 < 2; ++k2) {
#pragma unroll
        for (int i = 0; i < 16; ++i) s[k2][i] = 0.f;
#pragma unroll
        for (int kk = 0; kk < 8; ++kk) {
          const bf16x8 a = *(const bf16x8*)(cur + (k2 * 32 + r) * FK_S + kk * 32 + hh * 16);
          s[k2] = __builtin_amdgcn_mfma_f32_32x32x16_bf16(a, qf[kk], s[k2], 0, 0, 0);
        }
      }
      const float* ck = (const float*)(cur + 64 * FK_S + 128 * FV_S);
      float mx = -1e30f;
#pragma unroll
      for (int k2 = 0; k2 < 2; ++k2)
#pragma unroll
        for (int q = 0; q < 4; ++q) {
          const int key = k2 * 32 + 8 * q + 4 * hh;
          const f32x4 c4 = *(const f32x4*)(ck + key);
#pragma unroll
          for (int e = 0; e < 4; ++e) {
            const int kp = k0 + key + e;
            float z = s[k2][4 * q + e] + cq - c4[e];
            z = (kp >= PAD_ && kp <= qpos) ? z : -1e30f;
            s[k2][4 * q + e] = z;
            mx = fmaxf(mx, z);
          }
        }
      mx = fmaxf(mx, __shfl_xor(mx, 32));
      const float mn = fmaxf(m, mx);
      const float alpha = fexp2(m - mn);
      m = mn;
      lsum *= alpha;
#pragma unroll
      for (int mt = 0; mt < 4; ++mt)
#pragma unroll
        for (int i = 0; i < 16; ++i) O[mt][i] *= alpha;
#pragma unroll
      for (int k2 = 0; k2 < 2; ++k2) {
        unsigned pw[8];
#pragma unroll
        for (int e = 0; e < 8; ++e) {
          const float p0 = fexp2(s[k2][2 * e] - mn), p1 = fexp2(s[k2][2 * e + 1] - mn);
          lsum += p0 + p1;
          pw[e] = pk_bf16(p0, p1);
        }
#pragma unroll
        for (int s2 = 0; s2 < 2; ++s2) {
          union { uint4 u; bf16x8 v; } pb;
          pb.u = make_uint4(pw[4 * s2], pw[4 * s2 + 1], pw[4 * s2 + 2], pw[4 * s2 + 3]);
#pragma unroll
          for (int mt = 0; mt < 4; ++mt) {
            const char* vp = cur + 64 * FK_S + (mt * 32 + r) * FV_S + (k2 * 32 + 16 * s2 + 4 * hh) * 2;
            const uint2 lo = *(const uint2*)vp, hi = *(const uint2*)(vp + 16);
            union { uint4 u; bf16x8 v; } av;
            av.u = make_uint4(lo.x, lo.y, hi.x, hi.y);
            O[mt] = __builtin_amdgcn_mfma_f32_32x32x16_bf16(av.v, pb.v, O[mt], 0, 0, 0);
          }
        }
      }
    }
    if (more) FOX_LSTORE(lds + ((t + 1) & 1) * FOX_BUF);
    __syncthreads();
  }
  lsum += __shfl_xor(lsum, 32);
  const float inv = (qpos >= PAD_) ? 1.f / lsum : 0.f;
#pragma unroll
  for (int mt = 0; mt < 4; ++mt)
#pragma unroll
    for (int q = 0; q < 4; ++q) {
      const int dv = mt * 32 + 8 * q + 4 * hh;
      uint2 wv;
      wv.x = pk_bf16(O[mt][4 * q] * inv, O[mt][4 * q + 1] * inv);
      wv.y = pk_bf16(O[mt][4 * q + 2] * inv, O[mt][4 * q + 3] * inv);
      *(uint2*)(p.BR + qrow * LDB + 2048 + h * 128 + dv) = wv;
    }
}


DEV void cnorm_phase(const Params& p, const float* g) {
  const int lane = tid_() & 63;
  const int gw = (bid_() * blockDim.x + tid_()) >> 6, nw = (gridDim.x * blockDim.x) >> 6;
  for (int row = gw; row < M_; row += nw) {
    const uint2 raw = *(const uint2*)(p.PROJ + (long)row * LDP + 2048 + lane * 4);
    const float v[4] = {bflo(raw.x), bfhi(raw.x), bflo(raw.y), bfhi(raw.y)};
    float ss = v[0] * v[0] + v[1] * v[1] + v[2] * v[2] + v[3] * v[3];
#pragma unroll
    for (int o = 32; o > 0; o >>= 1) ss += __shfl_xor(ss, o);
    const float rs = rsqrtf(ss * (1.0f / 256.0f) + 1e-6f);
    const f32x4 gg = *(const f32x4*)(g + lane * 4);
    uint2 o;
    o.x = pk_bf16(v[0] * rs * gg[0], v[1] * rs * gg[1]);
    o.y = pk_bf16(v[2] * rs * gg[2], v[3] * rs * gg[3]);
    *(uint2*)(p.CN + (long)row * 256 + lane * 4) = o;
  }
}

DEV unsigned prune256(unsigned* buf, int cnt, int lane, unsigned* hist) {
  unsigned k[16];
#pragma unroll
  for (int i = 0; i < 16; ++i) k[i] = (i * 64 + lane < cnt) ? buf[i * 64 + lane] : 0u;
  unsigned prefix = 0;
  unsigned need = 256;
#pragma unroll 1
  for (int pass = 0; pass < 4; ++pass) {
    const int sh = 24 - 8 * pass;
    const unsigned himask = pass == 0 ? 0u : (0xFFFFFFFFu << (sh + 8));
    *(uint4*)(hist + lane * 4) = make_uint4(0u, 0u, 0u, 0u);
    asm volatile("s_waitcnt lgkmcnt(0)" ::: "memory");
#pragma unroll
    for (int i = 0; i < 16; ++i)
      if ((i * 64 + lane < cnt) && ((k[i] & himask) == prefix)) atomicAdd(hist + ((k[i] >> sh) & 255u), 1u);
    asm volatile("s_waitcnt lgkmcnt(0)" ::: "memory");
    const uint4 h4 = *(const uint4*)(hist + lane * 4);
    asm volatile("s_waitcnt lgkmcnt(0)" ::: "memory");
    const unsigned s3 = h4.w, s2 = s3 + h4.z, s1 = s2 + h4.y, s0 = s1 + h4.x;
    unsigned v = s0;
#pragma unroll
    for (int o = 1; o < 64; o <<= 1) { const unsigned t = __shfl_down(v, o); if (lane + o < 64) v += t; }
    const unsigned above = v - s0;
    const unsigned long long mk = __ballot(above + s0 >= need);
    const int ls = 63 - __clzll((long long)mk);
    int j = 0; unsigned gt = s1;
    if (above + s1 >= need) { j = 1; gt = s2; }
    if (above + s2 >= need) { j = 2; gt = s3; }
    if (above + s3 >= need) { j = 3; gt = 0u; }
    const unsigned dsel = (unsigned)__shfl((int)(lane * 4 + j), ls);
    const unsigned ngt = (unsigned)__shfl((int)(above + gt), ls);
    prefix |= dsel << sh;
    need -= ngt;
  }
  const unsigned T = prefix;
  int base = 0;
  const unsigned long long lt = (1ull << lane) - 1ull;
#pragma unroll
  for (int i = 0; i < 16; ++i) {
    const bool pass = (i * 64 + lane < cnt) && (k[i] >= T);
    const unsigned long long mk = __ballot(pass);
    if (pass) buf[base + __popcll(mk & lt)] = k[i];
    base += __popcll(mk);
  }
  return T;
}

DEV void index_unit(const Params& p, int b, int t0, char* lds) {
  const int tid = tid_(), lane = tid & 63, w = tid >> 6, r = lane & 31, hh = lane >> 5;
  unsigned* bufA = (unsigned*)lds + (w * 2) * 1024;
  unsigned* bufB = bufA + 1024;
  unsigned* mybuf = hh ? bufB : bufA;
  unsigned* hist = (unsigned*)(lds + 32768) + w * 256;
  const int tq = t0 + 2 * w + hh;
  const long rowq = (long)b * T_ + tq;
  if (t0 + 7 < PAD_) { if (r == 0) p.NIDX[rowq] = 0; return; }
  bf16x8 qa[4];
  {
    const int qsel = (r >> 2) & 1, head = (r & 3) + 4 * (r >> 3);
    const bf16_t* qp = p.PROJ + ((long)b * T_ + t0 + 2 * w + qsel) * LDP + 2304 + head * 64 + hh * 32;
#pragma unroll
    for (int kk = 0; kk < 4; ++kk) qa[kk] = *(const bf16x8*)(qp + kk * 8);
  }
  float wq[16];
#pragma unroll
  for (int q = 0; q < 4; ++q) {
    const f32x4 w4 = *(const f32x4*)(p.SMALL + rowq * 128 + 64 + 4 * q);
#pragma unroll
    for (int e = 0; e < 4; ++e) wq[4 * q + e] = w4[e] * 0.25f;
  }
  int cntA = 0, cntB = 0;
  unsigned thrA = 0, thrB = 0;
  const int tmax = t0 + 2 * w + 1;
  const bf16_t* kbase = p.IK16 + ((long)b * T_) * 64 + hh * 32;
  typedef __attribute__((address_space(3))) unsigned idx_lds_u32;
  typedef const __attribute__((address_space(1))) unsigned idx_glb_u32;
  char* ring = lds + 36864 + w * 8192;
  const bf16_t* kg = p.IK16 + ((long)b * T_) * 64;
#define IDX_DMA1(slot_, kb_, j)                                                                          \
  {                                                                                                      \
    const int _row = 8 * (j) + (lane >> 3);                                                              \
    int _k = (kb_) + _row; _k = _k < T_ ? _k : T_ - 1;                                                   \
    const int _c = (lane & 7) ^ ((_row >> 1) & 7);                                                       \
    __builtin_amdgcn_global_load_lds((idx_glb_u32*)(kg + (long)_k * 64 + _c * 8),                        \
                                     (idx_lds_u32*)(ring + (slot_) * 4096 + (j) * 1024 + lane * 16), 16, 0, 0); \
  }
#define IDX_DMA(slot_, kb_) { IDX_DMA1(slot_, kb_, 0) IDX_DMA1(slot_, kb_, 1) IDX_DMA1(slot_, kb_, 2) IDX_DMA1(slot_, kb_, 3) }
  const int fsw = (r >> 1) & 7;
  const int fo0 = r * 128 + (((hh * 4 + 0) ^ fsw) << 4), fo1 = r * 128 + (((hh * 4 + 1) ^ fsw) << 4);
  const int fo2 = r * 128 + (((hh * 4 + 2) ^ fsw) << 4), fo3 = r * 128 + (((hh * 4 + 3) ^ fsw) << 4);
  IDX_DMA(0, PAD_);
  int slot = 0;
  for (int kb = PAD_; kb <= tmax; kb += 32) {
    if (cntA > 992) { thrA = prune256(bufA, cntA, lane, hist); cntA = 256; }
    if (cntB > 992) { thrB = prune256(bufB, cntB, lane, hist); cntB = 256; }
    asm volatile("" ::: "memory");
    IDX_DMA(slot ^ 1, kb + 32);
    asm volatile("s_waitcnt vmcnt(4)" ::: "memory");
    const char* cur = ring + slot * 4096;
    const bf16x8 kc0 = *(const bf16x8*)(cur + fo0), kc1 = *(const bf16x8*)(cur + fo1);
    const bf16x8 kc2 = *(const bf16x8*)(cur + fo2), kc3 = *(const bf16x8*)(cur + fo3);
    slot ^= 1;
    const int key = kb + r;
    f32x16 acc;
#pragma unroll
    for (int i = 0; i < 16; ++i) acc[i] = 0.f;
    acc = __builtin_amdgcn_mfma_f32_32x32x16_bf16(qa[0], kc0, acc, 0, 0, 0);
    acc = __builtin_amdgcn_mfma_f32_32x32x16_bf16(qa[1], kc1, acc, 0, 0, 0);
    acc = __builtin_amdgcn_mfma_f32_32x32x16_bf16(qa[2], kc2, acc, 0, 0, 0);
    acc = __builtin_amdgcn_mfma_f32_32x32x16_bf16(qa[3], kc3, acc, 0, 0, 0);
    float sc = 0.f;
#pragma unroll
    for (int i = 0; i < 16; ++i) { const int xb = __float_as_int(acc[i]); sc += wq[i] * __int_as_float(xb > 0 ? xb : 0); }
    const unsigned ub = __float_as_uint(sc);
    const unsigned ord = ub ^ ((ub >> 31) ? 0xFFFFFFFFu : 0x80000000u);
    const unsigned packed = (ord & 0xFFFFC000u) | (unsigned)(16383 - key);
    const bool pass = (key <= tq) && (packed > (hh ? thrB : thrA));
    const unsigned long long mk = __ballot(pass);
    const unsigned mA = (unsigned)mk, mB = (unsigned)(mk >> 32);
    const unsigned mine = hh ? mB : mA;
    if (pass) mybuf[(hh ? cntB : cntA) + __popc(mine & ((1u << r) - 1u))] = packed;
    cntA += __popc(mA);
    cntB += __popc(mB);
  }
  asm volatile("s_waitcnt vmcnt(0)" ::: "memory");
#undef IDX_DMA
#undef IDX_DMA1
  if (cntA > 256) { prune256(bufA, cntA, lane, hist); cntA = 256; }
  if (cntB > 256) { prune256(bufB, cntB, lane, hist); cntB = 256; }
#pragma unroll
  for (int s = 0; s < 2; ++s) {
    const unsigned* bf = s ? bufB : bufA;
    const int cnt = s ? cntB : cntA;
    const long row = (long)b * T_ + t0 + 2 * w + s;
#pragma unroll
    for (int i = 0; i < 4; ++i) {
      const int j = i * 64 + lane;
      p.IDX[row * 256 + j] = (j < cnt) ? (16383 - (int)(bf[j] & 0x3FFFu)) : PAD_;
    }
    if (lane == 0) p.NIDX[row] = (t0 + 2 * w + s >= PAD_) ? cnt : 0;
  }
}

DEV void index_phase(const Params& p, int l, char* lds, int rep = 0) {
  for (;;) {
    const int u = pop_unit(p.CNT + 24 + l + rep * 16, lds);
    if (u >= 2080) break;
    const int b = u & 1, t0 = (1039 - (u >> 1)) * 8;
    index_unit(p, b, t0, lds);
  }
}

typedef short s16x4 __attribute__((ext_vector_type(4)));
DEV int t5_bucket(int dist) {
  const float d = (float)(dist < 1 ? 1 : dist);
  int large = 16 + (int)(__logf(d * 0.0625f) * (16.0f / 2.0794415416798357f));
  large = large < 31 ? large : 31;
  return dist < 16 ? dist : large;
}

constexpr int DRS = 528;
DEV void dsa_unit(const Params& p, int b, int t0, char* lds) {
  const int tid = tid_(), lane = tid & 63, w = tid >> 6, c16 = lane & 15, g = lane >> 4;
  const int tq = t0 + w;
  const long row = (long)b * T_ + tq;
  char* wl = lds + w * (32 * DRS);
  if (tq < PAD_) {
#pragma unroll
    for (int i = 0; i < 4; ++i) *(uint4*)(p.BR + row * LDB + (i * 64 + lane) * 8) = make_uint4(0, 0, 0, 0);
    return;
  }
  const int n = p.NIDX[row];
  const bf16_t* qptr0 = p.PROJ + row * LDP + (c16 & 7) * 256 + 8 * g;
  f32x4 O[16];
#pragma unroll
  for (int mt = 0; mt < 16; ++mt) O[mt] = (f32x4){0.f, 0.f, 0.f, 0.f};
  float m = -1e30f, lsum = 0.f;
  const int nch = (n + 31) >> 5;
  const int head = c16 & 7;
  for (int ch = 0; ch < nch; ++ch) {
    const int slot = ch * 32 + (lane & 31);
    const int myidx = (slot < n) ? p.IDX[row * 256 + slot] : PAD_;
#pragma unroll
    for (int i = 0; i < 16; ++i) {
      const int kr = 2 * i + (lane >> 5);
      const int kidx = __shfl(myidx, kr);
      const uint4 v = *(const uint4*)(p.CN + ((long)b * T_ + kidx) * 256 + (lane & 31) * 8);
      *(uint4*)(wl + kr * DRS + (lane & 31) * 16) = v;
    }
    __builtin_amdgcn_fence(__ATOMIC_RELEASE, "wavefront");
    asm volatile("s_waitcnt lgkmcnt(0)" ::: "memory");
    f32x4 s[2];
    s[0] = (f32x4){0.f, 0.f, 0.f, 0.f};
    s[1] = (f32x4){0.f, 0.f, 0.f, 0.f};
    {
      const bf16_t* qptr = qptr0;
      asm volatile("" : "+v"(qptr));
#pragma unroll
      for (int ks = 0; ks < 8; ++ks) {
        const bf16x8 qv = *(const bf16x8*)(qptr + ks * 32);
        const bf16x8 a0 = *(const bf16x8*)(wl + c16 * DRS + ks * 64 + g * 16);
        const bf16x8 a1 = *(const bf16x8*)(wl + (16 + c16) * DRS + ks * 64 + g * 16);
        s[0] = __builtin_amdgcn_mfma_f32_16x16x32_bf16(a0, qv, s[0], 0, 0, 0);
        s[1] = __builtin_amdgcn_mfma_f32_16x16x32_bf16(a1, qv, s[1], 0, 0, 0);
      }
    }
    float mx = -1e30f;
#pragma unroll
    for (int tl = 0; tl < 2; ++tl)
#pragma unroll
      for (int e = 0; e < 4; ++e) {
        const int kslot = tl * 16 + 4 * g + e;
        const int kidx = __shfl(myidx, kslot);
        const float bias = p.t5[t5_bucket(tq - kidx) * 8 + head] * 1.4426950408889634f;
        float z = s[tl][e] + bias;
        z = (ch * 32 + kslot < n) ? z : -1e30f;
        s[tl][e] = z;
        mx = fmaxf(mx, z);
      }
    mx = fmaxf(mx, __shfl_xor(mx, 16));
    mx = fmaxf(mx, __shfl_xor(mx, 32));
    const float mn = fmaxf(m, mx);
    const float alpha = fexp2(m - mn);
    m = mn;
    lsum *= alpha;
#pragma unroll
    for (int mt = 0; mt < 16; ++mt) O[mt] *= alpha;
    float pv[8];
#pragma unroll
    for (int tl = 0; tl < 2; ++tl)
#pragma unroll
      for (int e = 0; e < 4; ++e) { pv[tl * 4 + e] = fexp2(s[tl][e] - mn); lsum += pv[tl * 4 + e]; }
    union { uint4 u; bf16x8 v; } pb;
    pb.u = make_uint4(pk_bf16(pv[0], pv[1]), pk_bf16(pv[2], pv[3]), pk_bf16(pv[4], pv[5]), pk_bf16(pv[6], pv[7]));
    const int qq = c16 >> 2, pp = c16 & 3;
#pragma unroll
    for (int mt = 0; mt < 16; ++mt) {
      const char* a0 = wl + (4 * g + qq) * DRS + (mt * 16 + 4 * pp) * 2;
      const s16x4 lo = __builtin_amdgcn_ds_read_tr16_b64_v4i16((__attribute__((address_space(3))) s16x4*)a0);
      const s16x4 hi = __builtin_amdgcn_ds_read_tr16_b64_v4i16((__attribute__((address_space(3))) s16x4*)(a0 + 16 * DRS));
      bf16x8 av;
      av[0] = lo[0]; av[1] = lo[1]; av[2] = lo[2]; av[3] = lo[3];
      av[4] = hi[0]; av[5] = hi[1]; av[6] = hi[2]; av[7] = hi[3];
      O[mt] = __builtin_amdgcn_mfma_f32_16x16x32_bf16(av, pb.v, O[mt], 0, 0, 0);
    }
    asm volatile("s_waitcnt lgkmcnt(0)" ::: "memory");
  }
  lsum += __shfl_xor(lsum, 16);
  lsum += __shfl_xor(lsum, 32);
  const float inv = 1.f / lsum;
  if (c16 < 8) {
#pragma unroll
    for (int mt = 0; mt < 16; ++mt) {
      uint2 wv;
      wv.x = pk_bf16(O[mt][0] * inv, O[mt][1] * inv);
      wv.y = pk_bf16(O[mt][2] * inv, O[mt][3] * inv);
      *(uint2*)(p.BR + row * LDB + c16 * 256 + mt * 16 + 4 * g) = wv;
    }
  }
}

DEV void attn_phase(const Params& p, int l, char* lds, int rep = 0) {
  for (;;) {
    const int u = pop_unit(p.CNT + 16 + l + rep * 16, lds);
    if (u >= 1040 + 4160) break;
    if (u < 1040) {
      const int qt = 64 - (u >> 4), b = (u >> 3) & 1, h = u & 7;
      fox_unit(p, b, h, qt, lds);
    } else {
      const int v = u - 1040, b = v & 1, t0 = (v >> 1) * 4;
      dsa_unit(p, b, t0, lds);
    }
  }
}

constexpr int BRANCH_MASK = 7;
DEV void merge_phase(const Params& p, char* lds) {
  const int lane = tid_() & 63, wid = tid_() >> 6, wr = wid >> 1, wc = wid & 1, r = lane & 31, hh = lane >> 5;
  uint4* stb = (uint4*)p.STASH + (long)bid_() * (24 * 256) + tid_();
  f32x4* sto = (f32x4*)((uint4*)p.STASH + (long)bid_() * (24 * 256) + 8 * 256) + tid_();
  int jfirst = 0, jlast = 2;
  while (!((BRANCH_MASK >> jfirst) & 1)) ++jfirst;
  while (!((BRANCH_MASK >> jlast) & 1)) --jlast;
  TILE_LOOP(130, 16) {
#pragma unroll 1
    for (int j = jfirst; j <= jlast; ++j) {
      if (!((BRANCH_MASK >> j) & 1)) continue;
      {
        f32x16 ab[2][2];
        zero_acc(ab);
        const bf16_t* wb = j == 0 ? p.Wb0 : (j == 1 ? p.Wb1 : p.Wb2);
        const int kj = j == 0 ? 2048 : 1024;
        const int co = j == 0 ? 0 : (j == 1 ? 2048 : 3072);
        gemm_kloop(wb + (long)pn * 128 * kj, kj, p.BR + (long)pm * 128 * LDB + co, LDB, kj, ab, lds);
#pragma unroll
        for (int a = 0; a < 2; ++a)
#pragma unroll
          for (int c = 0; c < 2; ++c) {
            unsigned w[8];
#pragma unroll
            for (int e = 0; e < 8; ++e) w[e] = pk_bf16(ab[a][c][2 * e], ab[a][c][2 * e + 1]);
            stb[((a * 2 + c) * 2) * 256] = make_uint4(w[0], w[1], w[2], w[3]);
            stb[((a * 2 + c) * 2 + 1) * 256] = make_uint4(w[4], w[5], w[6], w[7]);
          }
      }
      f32x16 ag[2][2];
      zero_acc(ag);
      gemm_kloop(p.Wgt + ((long)j * 2048 + pn * 128) * D_, D_, p.H + (long)pm * 128 * D_, D_, D_, ag, lds);
#pragma unroll
      for (int mi = 0; mi < 2; ++mi)
#pragma unroll
        for (int ni = 0; ni < 2; ++ni) {
          const long tok = (long)pm * 128 + wc * 64 + ni * 32 + r;
          const uint4 s0 = stb[((mi * 2 + ni) * 2) * 256], s1 = stb[((mi * 2 + ni) * 2 + 1) * 256];
          const unsigned w[8] = {s0.x, s0.y, s0.z, s0.w, s1.x, s1.y, s1.z, s1.w};
#pragma unroll
          for (int q = 0; q < 4; ++q) {
            f32x4 v;
#pragma unroll
            for (int e = 0; e < 4; ++e) {
              const float g = 1.f / (1.f + __expf(-ag[mi][ni][4 * q + e]));
              const unsigned ww = w[2 * q + (e >> 1)];
              v[e] = g * ((e & 1) ? bfhi(ww) : bflo(ww));
            }
            if (j != jfirst) { const f32x4 o = sto[((mi * 2 + ni) * 4 + q) * 256]; v += o; }
            if (j != jlast) sto[((mi * 2 + ni) * 4 + q) * 256] = v;
            else {
              uint2 wv; wv.x = pk_bf16(v[0], v[1]); wv.y = pk_bf16(v[2], v[3]);
              *(uint2*)(lds + wid * (64 * 144) + (ni * 32 + r) * 144 + (mi * 32 + 8 * q + 4 * hh) * 2) = wv;
            }
          }
        }
    }
    asm volatile("s_waitcnt lgkmcnt(0)" ::: "memory");
    {
      const char* stg = lds + wid * (64 * 144);
      const int trow = lane >> 3, ch = lane & 7;
      bf16_t* dst = p.MERGED + ((long)pm * 128 + wc * 64 + trow) * D_ + pn * 128 + wr * 64 + ch * 8;
#pragma unroll
      for (int i = 0; i < 8; ++i) *(uint4*)(dst + (long)(8 * i) * D_) = *(const uint4*)(stg + (trow + 8 * i) * 144 + ch * 16);
    }
    __syncthreads();
  }
}

DEV void layer_body(const Params& p, const int l, char* lds, cg::grid_group& grid) {
    conv_ffn(p, p.ffn1_w1 + (long)l * D_ * DFF, p.ffn1_w3 + (long)l * D_ * DFF, p.ffn1_w2 + (long)l * DFF * D_, lds);
    conv_mixer(p, l, lds);
    if (l == 0) rope_table_phase(p);
    norm_phase(p, p.ffn1_norm + l * D_, p.H, l == 0 ? 1 : 0);
    grid.sync();
    ffn_up_phase(p, lds);
    grid.sync();
    resid_gemm_phase(p, p.W2t, p.HID, DFF, 0.5f, lds);
    grid.sync();
    norm_phase(p, p.mix_norm + l * D_, p.H, 0);
    grid.sync();
    proj_phase(p, lds);
    grid.sync();
    ret_kv_phase(p);
    fox_cum_phase(p, p.f_bias + l * 8);
    fox_norm_phase(p);
    cnorm_phase(p, p.kv_norm + l * 256);
    index_phase(p, l, lds);
    grid.sync();
    ret_scan_phase(p);
    attn_phase(p, l, lds);
    grid.sync();
    ret_out_phase(p, p.gn_w + l * 1024);
    grid.sync();
    merge_phase(p, lds);
    grid.sync();
    conv_ffn(p, p.ffn2_w1 + (long)l * D_ * DFF, p.ffn2_w3 + (long)l * D_ * DFF, p.ffn2_w2 + (long)l * DFF * D_, lds);
    resid_gemm_phase(p, p.Wot, p.MERGED, D_, 1.0f, lds);
    grid.sync();
    norm_phase(p, p.ffn2_norm + l * D_, p.H, 0);
    grid.sync();
    ffn_up_phase(p, lds);
    grid.sync();
    resid_gemm_phase(p, p.W2t, p.HID, DFF, 0.5f, lds);
    grid.sync();
}

__global__ void __launch_bounds__(256, 2) mega(Params p) {
  cg::grid_group grid = cg::this_grid();
  __shared__ __attribute__((aligned(16))) char lds[LDS_BYTES];
  if (bid_() == 0 && tid_() < 64) p.CNT[tid_()] = 0;
  layer_body(p, 0, lds, grid);
  layer_body(p, 1, lds, grid);
  final_norm_phase(p);
}

extern "C" void kernel_launch(void* const* d_in, const int* in_sizes, int n_in, void* d_out, int out_size, void* d_ws,
                              size_t ws_size, hipStream_t stream) {
  static int grid_blocks = 0;
  if (!grid_blocks) {
    int dev = 0, cus = 0, per_cu = 0;
    hipGetDevice(&dev);
    hipDeviceGetAttribute(&cus, hipDeviceAttributeMultiprocessorCount, dev);
    hipOccupancyMaxActiveBlocksPerMultiprocessor(&per_cu, mega, 256, 0);
    if (per_cu > 2) per_cu = 2;
    grid_blocks = (cus * per_cu) & ~7;
  }
  Params p{};
  const float* const* in = (const float* const*)d_in;
  p.x = in[0]; p.meta = in[1]; p.t5 = in[2]; p.ffn1_norm = in[3]; p.ffn1_w1 = in[4]; p.ffn1_w3 = in[5]; p.ffn1_w2 = in[6];
  p.mix_norm = in[7]; p.w_in = in[8]; p.kv_norm = in[9]; p.w_uk = in[10]; p.w_uv = in[11]; p.f_bias = in[12]; p.gn_w = in[13];
  p.w_branch = in[14]; p.w_out = in[15]; p.ffn2_norm = in[16]; p.ffn2_w1 = in[17]; p.ffn2_w3 = in[18]; p.ffn2_w2 = in[19];
  p.final_norm = in[20];
  p.out = (float*)d_out;
  char* w = (char*)d_ws;
  size_t off = 0;
  auto take = [&](size_t bytes) { char* r = w + off; off += (bytes + 255) & ~(size_t)255; return r; };
  p.CNT = (unsigned*)take(4096);
  p.W13 = (bf16_t*)take((size_t)2 * DFF * D_ * 2);
  p.W2t = (bf16_t*)take((size_t)D_ * DFF * 2);
  p.Wint = (bf16_t*)take((size_t)NIN * D_ * 2);
  p.Wgt = (bf16_t*)take((size_t)6144 * D_ * 2);
  p.Wb0 = (bf16_t*)take((size_t)D_ * 2048 * 2);
  p.Wb1 = (bf16_t*)take((size_t)D_ * 1024 * 2);
  p.Wb2 = (bf16_t*)take((size_t)D_ * 1024 * 2);
  p.Wot = (bf16_t*)take((size_t)D_ * D_ * 2);
  p.X = (float*)take((size_t)M_ * D_ * 4);
  p.H = (bf16_t*)take((size_t)M_ * D_ * 2);
  p.PROJ = (bf16_t*)take((size_t)M_ * LDP * 2);
  p.HID = p.PROJ;
  p.MERGED = p.PROJ;
  p.BR = (bf16_t*)take((size_t)M_ * LDB * 2);
  p.FVT = (bf16_t*)take((size_t)M_ * 1024 * 2);
  p.RKT = (bf16_t*)take((size_t)M_ * 512 * 2);
  p.RVT = (bf16_t*)take((size_t)M_ * 1024 * 2);
  p.CN = (bf16_t*)take((size_t)M_ * 256 * 2);
  p.IK16 = (bf16_t*)take((size_t)M_ * 64 * 2);
  p.SMALL = (float*)take((size_t)M_ * 128 * 4);
  p.CUM = (float*)take((size_t)M_ * 8 * 4);
  p.QN = (float*)take((size_t)16 * NCH * 4);
  p.KN = (float*)take((size_t)16 * NCH * 4);
  p.KV = (float*)take((size_t)NCH * 2 * 8 * 64 * 128 * 4);
  p.ST = p.KV;
  p.ROPE = (float*)take((size_t)T_ * 64 * 4);
  p.IDX = (int*)take((size_t)M_ * 256 * 4);
  p.NIDX = (int*)take((size_t)M_ * 4);
  p.STASH = (bf16_t*)take((size_t)512 * 24 * 256 * 16);
  if (off > ws_size) { fprintf(stderr, "workspace too small: need %zu have %zu\n", off, ws_size); return; }
  void* args[] = {&p};
  hipError_t e = hipLaunchCooperativeKernel((void*)mega, dim3(grid_blocks), dim3(256), args, 0, stream);
  if (e != hipSuccess) fprintf(stderr, "cooperative launch failed: %s (grid %d)\n", hipGetErrorString(e), grid_blocks);
}
```
